# Optimizing an MI355X kernel written in HIP

```python
import functools
import jax, jax.numpy as jnp
from jax import lax
import numpy as np

D_MODEL = 2048
BATCH = 4
SEQ = 2048
DEPTH = 1
DEC_BATCH = 128
DEC_SEQ = 8
PAST_LEN = 16384
PAGE_SIZE = 128

ATTN_WIDTH = D_MODEL // 2
CONV_CH = D_MODEL - ATTN_WIDTH
HEAD_DIM = 64
N_HEADS = ATTN_WIDTH // HEAD_DIM
N_KV_HEADS = max(1, N_HEADS // 4)
GROUP = N_HEADS // N_KV_HEADS
KV_WIDTH = N_KV_HEADS * HEAD_DIM
WINDOW = 128
BLOCK = 128
CONV_K = 3
D_FF = ((8 * D_MODEL // 3 + 255) // 256) * 256
IN_WIDTH = ATTN_WIDTH + 2 * KV_WIDTH + 3 * CONV_CH
SPLITS = [ATTN_WIDTH, ATTN_WIDTH + KV_WIDTH, ATTN_WIDTH + 2 * KV_WIDTH,
          ATTN_WIDTH + 2 * KV_WIDTH + CONV_CH, ATTN_WIDTH + 2 * KV_WIDTH + 2 * CONV_CH]
EPS = 1e-6
NEG = -1e30

kernel_name = "hymba_swa_sink_shortconv_convffn_step"


def _rmsnorm(x, g):
    xf = x.astype(jnp.float32)
    y = xf * lax.rsqrt(jnp.mean(xf * xf, axis=-1, keepdims=True) + EPS) * g.astype(jnp.float32)
    return y.astype(x.dtype)


def _alibi_slopes():
    h = jnp.arange(1, N_HEADS + 1, dtype=jnp.float32)
    return jnp.exp2(-8.0 * h / N_HEADS).reshape(N_KV_HEADS, GROUP)


def _sink_attend(q, k, v, dist, valid, sinks):
    s = jnp.einsum('...qkgd,...skd->...kgqs', q, k,
                   preferred_element_type=jnp.float32) * (HEAD_DIM ** -0.5)
    slopes = _alibi_slopes()[:, :, None, None]
    s = jnp.where(valid, s - slopes * dist, NEG)
    sink = sinks.astype(jnp.float32).reshape(N_KV_HEADS, GROUP)[:, :, None]
    m = jnp.maximum(jnp.max(s, axis=-1), sink)
    p = jnp.exp(s - m[..., None])
    denom = jnp.sum(p, axis=-1) + jnp.exp(sink - m)
    w = (p / denom[..., None]).astype(v.dtype)
    return jnp.einsum('...kgqs,...skd->...qkgd', w, v)


def _attend_prompt(q, k, v, sinks):
    b, t = q.shape[:2]
    nb = t // BLOCK
    qb = q.reshape(b, nb, BLOCK, N_KV_HEADS, GROUP, HEAD_DIM)

    def with_prev(a):
        a = a.reshape(b, nb, BLOCK, N_KV_HEADS, HEAD_DIM)
        prev = jnp.concatenate([jnp.zeros_like(a[:, :1]), a[:, :-1]], axis=1)
        return jnp.concatenate([prev, a], axis=2)

    qi = jnp.arange(BLOCK)[:, None]
    kj = jnp.arange(2 * BLOCK)[None, :]
    dist = qi - kj + BLOCK
    key_pos = jnp.arange(nb)[:, None, None] * BLOCK + kj[None] - BLOCK
    valid = (dist >= 0) & (dist <= WINDOW) & (key_pos >= 0)
    out = _sink_attend(qb, with_prev(k), with_prev(v), dist.astype(jnp.float32),
                       valid[:, None, None], sinks)
    return out.reshape(b, t, ATTN_WIDTH)


def _attend_sample(q, k, v, sinks, k_buf, v_buf):
    b, t = q.shape[:2]
    kk = jnp.concatenate([k_buf.astype(k.dtype), k], axis=1)
    vv = jnp.concatenate([v_buf.astype(v.dtype), v], axis=1)
    qi = jnp.arange(t)[:, None]
    kj = jnp.arange(WINDOW + t)[None, :]
    dist = qi + WINDOW - kj
    valid = (dist >= 0) & (dist <= WINDOW)
    out = _sink_attend(q.reshape(b, t, N_KV_HEADS, GROUP, HEAD_DIM), kk, vv,
                       dist.astype(jnp.float32), valid, sinks)
    return out.reshape(b, t, ATTN_WIDTH)


def _causal_dwconv(u, prev, w):
    t = u.shape[1]
    ext = jnp.concatenate([prev.astype(u.dtype), u], axis=1)
    out = w[0] * ext[:, 0:t]
    for j in range(1, CONV_K):
        out = out + w[j] * ext[:, j:j + t]
    return out, ext[:, t:]


def _layer(x, attend_fn, conv_prev, ffn_prev, g_attn_norm, w_in, attn_sinks, conv_w,
           g_out_attn, g_out_conv, w_out, g_ffn_norm, w_gate, w_up, ffn_conv_w, ffn_conv_b, w_down):
    b, t, _ = x.shape
    h = _rmsnorm(x, g_attn_norm)
    q, k, v, gate_b, gate_c, u_in = jnp.split(h @ w_in, SPLITS, axis=-1)
    k = k.reshape(b, t, N_KV_HEADS, HEAD_DIM)
    v = v.reshape(b, t, N_KV_HEADS, HEAD_DIM)
    attn = attend_fn(q, k, v, attn_sinks)
    conv_out, conv_state = _causal_dwconv(gate_c * u_in, conv_prev, conv_w)
    sconv = gate_b * conv_out
    mixed = jnp.concatenate([_rmsnorm(attn, g_out_attn), _rmsnorm(sconv, g_out_conv)], axis=-1)
    x = x + mixed @ w_out
    h = _rmsnorm(x, g_ffn_norm)
    a, ffn_state = _causal_dwconv(h @ w_gate, ffn_prev, ffn_conv_w)
    x = x + (jax.nn.silu(a + ffn_conv_b) * (h @ w_up)) @ w_down
    return x, k, v, conv_state, ffn_state


def setup_inputs(seed: int = 0) -> dict:
    key = jax.random.key(seed)
    ks = jax.random.split(key, 24)
    f32 = jnp.float32
    nrm = lambda k, shape, s=1.0: (jax.random.normal(k, shape, f32) * s).astype(f32)
    gain = lambda k, shape: 1.0 + 0.02 * jax.random.normal(k, shape, f32)
    return {
        "x_prompt": nrm(ks[0], (BATCH, SEQ, D_MODEL)),
        "x_sample": nrm(ks[1], (DEC_BATCH, DEC_SEQ, D_MODEL)),
        "cache_k_window": nrm(ks[2], (DEPTH, DEC_BATCH, WINDOW, N_KV_HEADS, HEAD_DIM)),
        "cache_v_window": nrm(ks[3], (DEPTH, DEC_BATCH, WINDOW, N_KV_HEADS, HEAD_DIM)),
        "state_conv": nrm(ks[4], (DEPTH, DEC_BATCH, CONV_K - 1, CONV_CH)),
        "state_ffn_conv": nrm(ks[5], (DEPTH, DEC_BATCH, CONV_K - 1, D_FF)),
        "g_attn_norm": gain(ks[6], (DEPTH, D_MODEL)),
        "w_in": nrm(ks[7], (DEPTH, D_MODEL, IN_WIDTH), D_MODEL ** -0.5),
        "attn_sinks": nrm(ks[8], (DEPTH, N_HEADS), 0.5),
        "conv_w": nrm(ks[9], (DEPTH, CONV_K, CONV_CH), CONV_K ** -0.5),
        "g_out_attn": gain(ks[10], (DEPTH, ATTN_WIDTH)),
        "g_out_conv": gain(ks[11], (DEPTH, CONV_CH)),
        "w_out": nrm(ks[12], (DEPTH, D_MODEL, D_MODEL), D_MODEL ** -0.5),
        "g_ffn_norm": gain(ks[13], (DEPTH, D_MODEL)),
        "w_gate": nrm(ks[14], (DEPTH, D_MODEL, D_FF), D_MODEL ** -0.5),
        "w_up": nrm(ks[15], (DEPTH, D_MODEL, D_FF), D_MODEL ** -0.5),
        "ffn_conv_w": nrm(ks[16], (DEPTH, CONV_K, D_FF), CONV_K ** -0.5),
        "ffn_conv_b": nrm(ks[17], (DEPTH, D_FF), 0.01),
        "w_down": nrm(ks[18], (DEPTH, D_FF, D_MODEL), D_FF ** -0.5),
        "g_final": gain(ks[19], (D_MODEL,)),
    }


def reference(x_prompt, x_sample, cache_k_window, cache_v_window, state_conv, state_ffn_conv,
              g_attn_norm, w_in, attn_sinks, conv_w, g_out_attn, g_out_conv, w_out,
              g_ffn_norm, w_gate, w_up, ffn_conv_w, ffn_conv_b, w_down, g_final):
    yp, ys = x_prompt, x_sample
    bp = x_prompt.shape[0]
    kwp, vwp, cvp, ffp = [], [], [], []
    kws, vws, cvs, ffs = [], [], [], []
    for l in range(DEPTH):
        w = (g_attn_norm[l], w_in[l], attn_sinks[l], conv_w[l], g_out_attn[l], g_out_conv[l],
             w_out[l], g_ffn_norm[l], w_gate[l], w_up[l], ffn_conv_w[l], ffn_conv_b[l], w_down[l])
        conv0 = jnp.zeros((bp, CONV_K - 1, CONV_CH), yp.dtype)
        ffn0 = jnp.zeros((bp, CONV_K - 1, D_FF), yp.dtype)
        yp, kp, vp, cp, fp = _layer(yp, _attend_prompt, conv0, ffn0, *w)
        kwp.append(kp[:, -WINDOW:])
        vwp.append(vp[:, -WINDOW:])
        cvp.append(cp)
        ffp.append(fp)
        att_s = functools.partial(_attend_sample, k_buf=cache_k_window[l], v_buf=cache_v_window[l])
        ys, k_s, v_s, c_s, f_s = _layer(ys, att_s, state_conv[l], state_ffn_conv[l], *w)
        kws.append(jnp.concatenate([cache_k_window[l].astype(k_s.dtype), k_s], axis=1)[:, -WINDOW:])
        vws.append(jnp.concatenate([cache_v_window[l].astype(v_s.dtype), v_s], axis=1)[:, -WINDOW:])
        cvs.append(c_s)
        ffs.append(f_s)
    y_prompt = _rmsnorm(yp, g_final)
    y_sample = _rmsnorm(ys, g_final)
    return (y_prompt, y_sample,
            jnp.stack(kwp), jnp.stack(vwp), jnp.stack(cvp), jnp.stack(ffp),
            jnp.stack(kws), jnp.stack(vws), jnp.stack(cvs), jnp.stack(ffs))
```

```cpp
#include <hip/hip_runtime.h>
#include <hip/hip_cooperative_groups.h>
#include <cstdio>
#include <cstdint>
namespace cg = cooperative_groups;
namespace pg8 {
#define PG8_LAS __attribute__((address_space(3)))
typedef unsigned short bf16_t;
typedef short bf16x8 __attribute__((ext_vector_type(8)));
typedef float f32x4 __attribute__((ext_vector_type(4)));
typedef unsigned u32x4 __attribute__((ext_vector_type(4)));
constexpr int BM = 256, BK = 64, HALF = 128, HTB = HALF * BK * 2  , STAGE_BYTES = 8 * HTB, NXCD = 8, WGM = 8;

__host__ __device__ __forceinline__ int lds_byte(int r, int c) { const int st = (r >> 4) * 2 + (c >> 5), rr = r & 15, cc = c & 31, ob = rr * 64 + cc * 2; return st * 1024 + (ob ^ (((ob >> 9) & 1) << 5)); }
__host__ __device__ __forceinline__ void stage_rc(int b, int& R, int& C) { const int st = b / 1024, sb = b % 1024, swz = sb ^ (((sb >> 9) & 1) << 5); R = (st >> 1) * 16 + swz / 64; C = (st & 1) * 32 + (swz % 64) / 2; }
__host__ __device__ __forceinline__ int perm32(int rho) { const int n = rho >> 4, i = rho & 15; return 8 * (i >> 2) + 4 * n + (i & 3); }

struct Unit { int pm, pn; };
struct Gemm { const bf16_t* A; const bf16_t* Bt; int M, N, K; };

struct StaticOrder {
    int nM, nN, nwg, G, c;
    __host__ __device__ void init(int M, int N, int G_, int c_) { nM = M / BM; nN = N / BM; nwg = nM * nN; G = G_; c = c_; }
    __host__ __device__ bool next(int i, Unit& u) const {
        const long L = (long)i * G + c; if (L >= nwg) return false;
        int wgid = (int)L; { const int q = nwg / NXCD, r = nwg % NXCD, xcd = wgid % NXCD, off = wgid / NXCD; wgid = (xcd < r ? xcd * (q + 1) : r * (q + 1) + (xcd - r) * q) + off; }
        const int nig = WGM * nN, gid = wgid / nig, fm = gid * WGM, gsz = (nM - fm) < WGM ? (nM - fm) : WGM;
        u.pm = fm + ((wgid % nig) % gsz); u.pn = (wgid % nig) / gsz; return true;
    }
    __device__ __forceinline__ void a_ready(const Unit&) const {}
    __device__ __forceinline__ void done(const Unit&) const {}
};

__device__ __forceinline__ unsigned cvt_pk_bf16(float lo, float hi) { unsigned r; asm volatile("v_cvt_pk_bf16_f32 %0, %1, %2" : "=v"(r) : "v"(lo), "v"(hi)); return r; }
typedef float f32x2 __attribute__((ext_vector_type(2)));
__device__ __forceinline__ f32x2 gelu_pk(f32x2 v) {
    const f32x2 av = __builtin_elementwise_abs(v), d = av * 0.2316418882f + 1.0f;
    f32x2 t; t.x = __builtin_amdgcn_rcpf(d.x); t.y = __builtin_amdgcn_rcpf(d.y);
    f32x2 q = t * 0.5307027145f + (-0.7265760135f); q = q * t + 0.7107068705f; q = q * t + (-0.142248368f); q = q * t + 0.127414796f; q = q * t;
    const f32x2 s = (v * v) * (-0.72134752044f);
    f32x2 e; e.x = __builtin_amdgcn_exp2f(s.x); e.y = __builtin_amdgcn_exp2f(s.y);
    const f32x2 m = v * (q * e), r = v - m;
    f32x2 o; o.x = v.x < 0.f ? m.x : r.x; o.y = v.y < 0.f ? m.y : r.y; return o;
}

template <int ACT  > struct EpiBf16 {
    static constexpr bool PERM = true, AFTER_DRAIN = false; static_assert(ACT == 0 || ACT == 1, "EpiBf16: ACT is 0 (none) or 1 (gelu_pk)");
    bf16_t* O; int ldc; const float* bias; int split_cols; size_t split_stride; float scale0;
    __device__ __forceinline__ void operator()(const f32x4 (&acc)[2][2][4][2], const Unit& u, int wr, int wc, int fr, int fq) const {
        const int row0 = u.pm * BM + wr * 64 + fr; int colt = u.pn * BM; bf16_t* base = O;
        float sc = 1.f; if (split_cols) { const int t = colt / split_cols; base += (size_t)t * split_stride; colt -= t * split_cols; if (t == 0) sc = scale0; }
        const int col0 = colt + wc * 32 + 8 * fq, bcol0 = u.pn * BM + wc * 32 + 8 * fq;
        f32x4 bv[2][2];
#pragma unroll
        for (int bj = 0; bj < 2; ++bj)
#pragma unroll
            for (int n = 0; n < 2; ++n) bv[bj][n] = bias ? *(const f32x4*)(bias + bcol0 + bj * HALF + 4 * n) : (f32x4){0.f, 0.f, 0.f, 0.f};
#pragma unroll
        for (int ai = 0; ai < 2; ++ai)
#pragma unroll
            for (int m = 0; m < 4; ++m) { bf16_t* rowp = base + (size_t)(row0 + ai * HALF + m * 16) * ldc + col0;
#pragma unroll
                for (int bj = 0; bj < 2; ++bj) { f32x4 v0 = acc[ai][bj][m][0] + bv[bj][0], v1 = acc[ai][bj][m][1] + bv[bj][1];
                    if (ACT == 1) { f32x2 a = gelu_pk((f32x2){v0[0], v0[1]}), b = gelu_pk((f32x2){v0[2], v0[3]}), c = gelu_pk((f32x2){v1[0], v1[1]}), d = gelu_pk((f32x2){v1[2], v1[3]});
                        v0 = (f32x4){a.x, a.y, b.x, b.y}; v1 = (f32x4){c.x, c.y, d.x, d.y}; }
                    v0 = v0 * sc; v1 = v1 * sc; u32x4 w; w.x = cvt_pk_bf16(v0[0], v0[1]); w.y = cvt_pk_bf16(v0[2], v0[3]); w.z = cvt_pk_bf16(v1[0], v1[1]); w.w = cvt_pk_bf16(v1[2], v1[3]);
                    *(u32x4*)(rowp + bj * HALF) = w; } }
    }
};
template <class Epi, class Sched, bool ALIGN_EPI = false, bool SP2 = false>
__device__ __forceinline__ void gemm_phase(PG8_LAS unsigned char* lds, const Gemm g, const Sched& S, const Epi& E) {
    const int tid = threadIdx.x, wid = __builtin_amdgcn_readfirstlane(tid >> 6), lane = tid & 63, wr = wid >> 2, wc = wid & 3, fr = lane & 15, fq = lane >> 4;
    const int K = g.K, nt = K / BK;
    unsigned voffA[2], voffB[2];
#pragma unroll
    for (int i = 0; i < 2; ++i) { int R, C; stage_rc(tid * 16 + i * 8192, R, C); const int Rb = Epi::PERM ? ((R & ~31) + perm32(R & 31)) : R;
        voffA[i] = (unsigned)(R * K + C) * 2u; voffB[i] = (unsigned)(Rb * K + C) * 2u; }
    const size_t kstep = (size_t)(BK * 2);
    const size_t hstep = (size_t)HALF * K * 2;
    const size_t tstep = 2 * hstep;
    const unsigned ldsw = (unsigned)wid * 1024u;
    const int aoff = lds_byte(wr * 64 + fr, fq * 8), boff = lds_byte(wc * 32 + fr, fq * 8);
#define PG8_SA(b, h) (((b) * 2 + (h)) * HTB)
#define PG8_SB(b, h) ((4 + (b) * 2 + (h)) * HTB)
#define PG8_STAGE(bufoff, gbase, voff) do { _Pragma("unroll") for (int _i = 0; _i < 2; ++_i) \
        __builtin_amdgcn_global_load_lds((const unsigned*)((const char*)(gbase) + (voff)[_i]), (PG8_LAS unsigned*)(lds + (bufoff) + ldsw + _i * 8192), 16, 0, 0); } while (0)
#define PG8_LDA(dst, b, h) do { _Pragma("unroll") for (int m = 0; m < 4; ++m) _Pragma("unroll") for (int k = 0; k < 2; ++k) dst[m][k] = *(const PG8_LAS bf16x8*)(lds + PG8_SA(b, h) + aoff + m * 2048 + k * 1024); } while (0)
#define PG8_LDB(dst, b, h) do { _Pragma("unroll") for (int n = 0; n < 2; ++n) _Pragma("unroll") for (int k = 0; k < 2; ++k) dst[n][k] = *(const PG8_LAS bf16x8*)(lds + PG8_SB(b, h) + boff + n * 2048 + k * 1024); } while (0)
#define PG8_MMA(ai, bj, At, Bt) do { __builtin_amdgcn_s_setprio(1); _Pragma("unroll") for (int m = 0; m < 4; ++m) _Pragma("unroll") for (int n = 0; n < 2; ++n) _Pragma("unroll") for (int k = 0; k < 2; ++k) \
        acc[ai][bj][m][n] = __builtin_amdgcn_mfma_f32_16x16x32_bf16(Bt[n][k], At[m][k], acc[ai][bj][m][n], 0, 0, 0); __builtin_amdgcn_s_setprio(0); } while (0)
#define PG8_WAIT_V(n) asm volatile("s_waitcnt vmcnt(" #n ")" ::: "memory")
#define PG8_WAIT_L(n) asm volatile("s_waitcnt lgkmcnt(" #n ")" ::: "memory")
#define PG8_BAR __builtin_amdgcn_s_barrier()
#define PG8_SCHED __builtin_amdgcn_sched_barrier(0)
    Unit cur, nxt; int ui = 0;
    if (!S.next(0, cur)) return;
    f32x4 acc[2][2][4][2];
#pragma unroll
    for (int a = 0; a < 2; ++a)
#pragma unroll
        for (int b = 0; b < 2; ++b)
#pragma unroll
            for (int m = 0; m < 4; ++m)
#pragma unroll
                for (int n = 0; n < 2; ++n) acc[a][b][m][n] = (f32x4){0.f, 0.f, 0.f, 0.f};
    bf16x8 At[4][2], B0[2][2], B1[2][2];
    const char* cA = (const char*)g.A + (size_t)cur.pm * tstep; const char* cB = (const char*)g.Bt + (size_t)cur.pn * tstep;
    S.a_ready(cur);
    if constexpr (SP2) {
        PG8_STAGE(PG8_SB(0, 0), cB, voffB); PG8_STAGE(PG8_SB(0, 1), cB + hstep, voffB); PG8_STAGE(PG8_SA(0, 0), cA, voffA); PG8_STAGE(PG8_SA(0, 1), cA + hstep, voffA);
        if (wr == 1) PG8_BAR;
        PG8_WAIT_V(2); PG8_BAR;
        PG8_STAGE(PG8_SB(1, 0), cB + kstep, voffB); PG8_STAGE(PG8_SA(1, 0), cA + kstep, voffA); PG8_STAGE(PG8_SB(1, 1), cB + hstep + kstep, voffB);
        PG8_WAIT_V(6); PG8_BAR;
    } else {
        PG8_STAGE(PG8_SB(0, 0), cB, voffB); PG8_STAGE(PG8_SA(0, 0), cA, voffA); PG8_STAGE(PG8_SB(0, 1), cB + hstep, voffB); PG8_STAGE(PG8_SA(0, 1), cA + hstep, voffA);
        if (wr == 1) PG8_BAR;
        PG8_WAIT_V(4); PG8_BAR;
        PG8_STAGE(PG8_SB(1, 0), cB + kstep, voffB); PG8_STAGE(PG8_SA(1, 0), cA + kstep, voffA); PG8_STAGE(PG8_SB(1, 1), cB + hstep + kstep, voffB);
        PG8_WAIT_V(6); PG8_BAR;
    }
    for (;;) {
        const bool has_next = S.next(ui + 1, nxt);
        const char* nA = has_next ? (const char*)g.A + (size_t)nxt.pm * tstep : cA; const char* nB = has_next ? (const char*)g.Bt + (size_t)nxt.pn * tstep : cB;
        for (int t = 0; t < nt; t += 2) {
            const bool last = (t == nt - 2);
            const char* a1 = cA + (size_t)(t + 1) * kstep;
            const char* a2 = last ? nA : cA + (size_t)(t + 2) * kstep; const char* b2 = last ? nB : cB + (size_t)(t + 2) * kstep;
            const char* a3 = a2 + kstep; const char* b3 = b2 + kstep;
            if (last && has_next) S.a_ready(nxt);
            if constexpr (SP2) {
            PG8_LDB(B0, 0, 0); PG8_LDB(B1, 0, 1); PG8_SCHED; PG8_LDA(At, 0, 0); PG8_STAGE(PG8_SA(1, 1), a1 + hstep, voffA);
            PG8_WAIT_V(8); PG8_WAIT_L(0); PG8_BAR; PG8_MMA(0, 0, At, B0); PG8_MMA(0, 1, At, B1); PG8_BAR; PG8_SCHED;
            PG8_LDA(At, 0, 1); PG8_STAGE(PG8_SB(0, 0), b2, voffB); PG8_STAGE(PG8_SB(0, 1), b2 + hstep, voffB); PG8_STAGE(PG8_SA(0, 0), a2, voffA);
            PG8_WAIT_V(8); PG8_WAIT_L(0); PG8_BAR; PG8_MMA(1, 0, At, B0); PG8_MMA(1, 1, At, B1); PG8_BAR; PG8_SCHED;
            PG8_LDB(B0, 1, 0); PG8_LDB(B1, 1, 1); PG8_SCHED; PG8_LDA(At, 1, 0); PG8_STAGE(PG8_SA(0, 1), a2 + hstep, voffA);
            PG8_WAIT_V(8); PG8_WAIT_L(0); PG8_BAR; PG8_MMA(0, 0, At, B0); PG8_MMA(0, 1, At, B1); PG8_BAR; PG8_SCHED;
            PG8_LDA(At, 1, 1); PG8_STAGE(PG8_SB(1, 0), b3, voffB); PG8_STAGE(PG8_SB(1, 1), b3 + hstep, voffB); PG8_STAGE(PG8_SA(1, 0), a3, voffA);
            PG8_WAIT_V(8); PG8_WAIT_L(0); PG8_BAR; PG8_MMA(1, 0, At, B0); PG8_MMA(1, 1, At, B1); PG8_BAR; PG8_SCHED;
            } else {
            PG8_LDB(B0, 0, 0); PG8_SCHED; PG8_LDA(At, 0, 0); PG8_STAGE(PG8_SA(1, 1), a1 + hstep, voffA);
            PG8_WAIT_L(8); PG8_BAR; PG8_WAIT_L(0); PG8_MMA(0, 0, At, B0); PG8_BAR; PG8_SCHED;
            PG8_LDB(B1, 0, 1); PG8_STAGE(PG8_SB(0, 0), b2, voffB);
            PG8_BAR; PG8_WAIT_L(0); PG8_MMA(0, 1, At, B1); PG8_BAR;
            PG8_LDA(At, 0, 1); PG8_STAGE(PG8_SA(0, 0), a2, voffA);
            PG8_BAR; PG8_WAIT_L(0); PG8_MMA(1, 0, At, B0); PG8_BAR; PG8_SCHED;
            PG8_STAGE(PG8_SB(0, 1), b2 + hstep, voffB);
            PG8_WAIT_V(6); PG8_BAR; PG8_MMA(1, 1, At, B1); PG8_BAR;
            PG8_LDB(B0, 1, 0); PG8_SCHED; PG8_LDA(At, 1, 0); PG8_STAGE(PG8_SA(0, 1), a2 + hstep, voffA);
            PG8_WAIT_L(8); PG8_BAR; PG8_WAIT_L(0); PG8_MMA(0, 0, At, B0); PG8_BAR; PG8_SCHED;
            PG8_LDB(B1, 1, 1); PG8_STAGE(PG8_SB(1, 0), b3, voffB);
            PG8_BAR; PG8_WAIT_L(0); PG8_MMA(0, 1, At, B1); PG8_BAR;
            PG8_LDA(At, 1, 1); PG8_STAGE(PG8_SA(1, 0), a3, voffA);
            PG8_BAR; PG8_WAIT_L(0); PG8_MMA(1, 0, At, B0); PG8_BAR; PG8_SCHED;
            PG8_STAGE(PG8_SB(1, 1), b3 + hstep, voffB);
            PG8_WAIT_V(6); PG8_BAR; PG8_MMA(1, 1, At, B1); PG8_BAR;
            }
        }
        if constexpr (ALIGN_EPI) { if (wr == 0) PG8_BAR; }
        if constexpr (!Epi::AFTER_DRAIN) { E(acc, cur, wr, wc, fr, fq); S.done(cur); }
        if (!has_next) break;
#pragma unroll
        for (int a = 0; a < 2; ++a)
#pragma unroll
            for (int b = 0; b < 2; ++b)
#pragma unroll
                for (int m = 0; m < 4; ++m)
#pragma unroll
                    for (int n = 0; n < 2; ++n) acc[a][b][m][n] = (f32x4){0.f, 0.f, 0.f, 0.f};
        cur = nxt; cA = nA; cB = nB; ++ui;
        if constexpr (ALIGN_EPI) { if (wr == 1) PG8_BAR; }
    }
    PG8_WAIT_V(0);
    if constexpr (!ALIGN_EPI) { if (wr == 0) PG8_BAR; }
    PG8_BAR;
    if constexpr (Epi::AFTER_DRAIN) { E.fused(acc, cur, wr, wc, fr, fq, lds, wid, lane); S.done(cur); }
#undef PG8_SA
#undef PG8_SB
#undef PG8_STAGE
#undef PG8_LDA
#undef PG8_LDB
#undef PG8_MMA
#undef PG8_WAIT_V
#undef PG8_WAIT_L
#undef PG8_BAR
#undef PG8_SCHED
}
}

namespace pg8 {
struct EpiRes {
    static constexpr bool PERM = true, AFTER_DRAIN = false;
    const float* xp; const float* xs; float* out; bf16_t* xb; float* ss;
    __device__ __forceinline__ void operator()(const f32x4 (&acc)[2][2][4][2], const Unit& u, int wr, int wc, int fr, int fq) const {
#pragma unroll
        for (int ai = 0; ai < 2; ++ai)
#pragma unroll
            for (int m = 0; m < 4; ++m) {
                const int row = u.pm * BM + ai * HALF + wr * 64 + m * 16 + fr;
                const float* src = row < 8192 ? xp + (size_t)row * 2048 : xs + (size_t)(row - 8192) * 2048;
                float s = 0.f;
#pragma unroll
                for (int bj = 0; bj < 2; ++bj) {
                    const int col = u.pn * BM + bj * HALF + wc * 32 + 8 * fq;
                    const f32x4 a0 = *(const f32x4*)(src + col), a1 = *(const f32x4*)(src + col + 4);
                    const f32x4 v0 = acc[ai][bj][m][0] + a0, v1 = acc[ai][bj][m][1] + a1;
                    *(f32x4*)(out + (size_t)row * 2048 + col) = v0; *(f32x4*)(out + (size_t)row * 2048 + col + 4) = v1;
                    if (xb) { u32x4 w; w.x = cvt_pk_bf16(v0[0], v0[1]); w.y = cvt_pk_bf16(v0[2], v0[3]); w.z = cvt_pk_bf16(v1[0], v1[1]); w.w = cvt_pk_bf16(v1[2], v1[3]);
                        *(u32x4*)(xb + (size_t)row * 2048 + col) = w; }
                    s += (v0[0] * v0[0] + v0[1] * v0[1]) + (v0[2] * v0[2] + v0[3] * v0[3]) + (v1[0] * v1[0] + v1[1] * v1[1]) + (v1[2] * v1[2] + v1[3] * v1[3]);
                }
                if (ss) { s += __shfl_xor(s, 16); s += __shfl_xor(s, 32); if (fq == 0) atomicAdd(ss + row, s); }
            }
    }
};

__device__ __forceinline__ float silu_f(float a) { return a * __builtin_amdgcn_rcpf(1.0f + __expf(-a)); }

struct EpiGU {
    static constexpr bool PERM = true, AFTER_DRAIN = false;
    bf16_t* HM; const float* ss1; const float* cw; const float* cb; const float* st;
    float* SG; float* SU; float* TG; float* ffp; float* ffs;
    __device__ __forceinline__ void operator()(const f32x4 (&acc)[2][2][4][2], const Unit& u, int wr, int wc, int fr, int fq) const {
        const int lane = fq * 16 + fr;
        const int col = u.pn * 128 + wc * 32 + 8 * fq;
        const int src1 = (lane & 48) | ((fr - 1) & 15), src2 = (lane & 48) | ((fr - 2) & 15);
        float w0[8], w1[8], w2[8], bb[8];
#pragma unroll
        for (int e = 0; e < 8; ++e) { w0[e] = cw[col + e]; w1[e] = cw[5632 + col + e]; w2[e] = cw[2 * 5632 + col + e]; bb[e] = cb[col + e]; }
        const bool samp = u.pm >= 32;
#pragma unroll
        for (int ai = 0; ai < 2; ++ai) {
            const int rb = u.pm * BM + ai * HALF + wr * 64, blk = rb >> 6;
            float r1p[8], r2p[8];
#pragma unroll
            for (int e = 0; e < 8; ++e) { r1p[e] = 0.f; r2p[e] = 0.f; }
#pragma unroll
            for (int m = 0; m < 4; ++m) {
                const int row = rb + 16 * m + fr;
                const float rs = rsqrtf(ss1[row] * (1.0f / 2048.0f) + 1e-6f);
                float g[8], up[8], r1[8], r2[8], p1[8], p2[8];
#pragma unroll
                for (int n = 0; n < 2; ++n)
#pragma unroll
                    for (int j = 0; j < 4; ++j) { g[4 * n + j] = acc[ai][0][m][n][j] * rs; up[4 * n + j] = acc[ai][1][m][n][j] * rs; }
#pragma unroll
                for (int e = 0; e < 8; ++e) { r1[e] = __shfl(g[e], src1); r2[e] = __shfl(g[e], src2); }
                bool do_store = true;
                if (!samp) {
#pragma unroll
                    for (int e = 0; e < 8; ++e) { p1[e] = fr >= 1 ? r1[e] : r1p[e]; p2[e] = fr >= 2 ? r2[e] : r2p[e]; }
                    if (m == 0 && fr < 2) {
                        float* sg = SG + (size_t)(blk * 2 + fr) * 5632 + col; float* su = SU + (size_t)(blk * 2 + fr) * 5632 + col;
                        *(f32x4*)sg = (f32x4){g[0], g[1], g[2], g[3]}; *(f32x4*)(sg + 4) = (f32x4){g[4], g[5], g[6], g[7]};
                        *(f32x4*)su = (f32x4){up[0], up[1], up[2], up[3]}; *(f32x4*)(su + 4) = (f32x4){up[4], up[5], up[6], up[7]};
                        do_store = false;
                    }
                    if (m == 3 && fr >= 14) {
                        float* tg = TG + (size_t)(blk * 2 + fr - 14) * 5632 + col;
                        *(f32x4*)tg = (f32x4){g[0], g[1], g[2], g[3]}; *(f32x4*)(tg + 4) = (f32x4){g[4], g[5], g[6], g[7]};
                        if ((blk & 31) == 31) { float* fo = ffp + (size_t)((blk >> 5) * 2 + fr - 14) * 5632 + col;
                            *(f32x4*)fo = (f32x4){g[0], g[1], g[2], g[3]}; *(f32x4*)(fo + 4) = (f32x4){g[4], g[5], g[6], g[7]}; }
                    }
                } else {
                    const int t = fr & 7, b = (row - 8192) >> 3;
                    float s0[8], s1[8];
#pragma unroll
                    for (int e = 0; e < 8; ++e) { s0[e] = 0.f; s1[e] = 0.f; }
                    if (t < 2) {
                        const float* sp = st + (size_t)(b * 2) * 5632 + col;
#pragma unroll
                        for (int e = 0; e < 8; ++e) { s0[e] = sp[e]; s1[e] = sp[5632 + e]; }
                    }
#pragma unroll
                    for (int e = 0; e < 8; ++e) { p1[e] = t >= 1 ? r1[e] : s1[e]; p2[e] = t >= 2 ? r2[e] : (t == 1 ? s1[e] : s0[e]); }
                    if (t >= 6) { float* fo = ffs + (size_t)(b * 2 + t - 6) * 5632 + col;
                        *(f32x4*)fo = (f32x4){g[0], g[1], g[2], g[3]}; *(f32x4*)(fo + 4) = (f32x4){g[4], g[5], g[6], g[7]}; }
                }
                if (do_store) {
                    float h[8];
#pragma unroll
                    for (int e = 0; e < 8; ++e) { const float a = w0[e] * p2[e] + w1[e] * p1[e] + w2[e] * g[e] + bb[e]; h[e] = silu_f(a) * up[e]; }
                    u32x4 w; w.x = cvt_pk_bf16(h[0], h[1]); w.y = cvt_pk_bf16(h[2], h[3]); w.z = cvt_pk_bf16(h[4], h[5]); w.w = cvt_pk_bf16(h[6], h[7]);
                    *(u32x4*)(HM + (size_t)row * 5632 + col) = w;
                }
#pragma unroll
                for (int e = 0; e < 8; ++e) { r1p[e] = r1[e]; r2p[e] = r2[e]; }
            }
        }
    }
};
}

#define LAS __attribute__((address_space(3)))
typedef unsigned short bf16;
typedef unsigned v4u __attribute__((ext_vector_type(4)));
typedef unsigned v2u __attribute__((ext_vector_type(2)));
typedef float f32x4 __attribute__((ext_vector_type(4)));
typedef short bf16x8 __attribute__((ext_vector_type(8)));

constexpr int DM = 2048, MP = 8192, MS = 1024, MT = 9216, SEQ = 2048, NIN = 4608, DFF = 5632;
constexpr int QK_OFF = 1024, QV_OFF = 1280, QB_OFF = 1536, QC_OFF = 2560, QU_OFF = 3584;
constexpr int NWAVES = 8, NTHR = 512;
constexpr int LDS_BYTES = 147456;
constexpr float EPS = 1e-6f;

constexpr size_t O_Y = 0, O_KWP = 18874368, O_VWP = 19005440, O_CVP = 19136512, O_FFP = 19144704,
                 O_KWS = 19189760, O_VWS = 23384064, O_CVS = 27578368, O_FFS = 27840512, O_END = 29282304;
constexpr size_t MiB = 1u << 20;
constexpr size_t WS_SS1 = 0;
constexpr size_t WS_WIN = 1 * MiB;
constexpr size_t WS_WOUT = 19 * MiB;
constexpr size_t WS_WGU = 27 * MiB;
constexpr size_t WS_WDN = 71 * MiB;
constexpr size_t WS_H = 93 * MiB;
constexpr size_t WS_MIX = 129 * MiB;
constexpr size_t WS_QKV = 165 * MiB;
constexpr size_t WS_ATT = 246 * MiB;
constexpr size_t WS_HM = 165 * MiB;
constexpr size_t WS_SG = 264 * MiB, WS_SU = 271 * MiB, WS_TG = 278 * MiB, WS_END = 285 * MiB;

struct Args { const float* in[20]; float* out; unsigned char* ws; int ph_lo, ph_hi; };

__device__ __forceinline__ unsigned f2bf(float f) { unsigned u = __builtin_bit_cast(unsigned, f); return (u + 0x7fffu + ((u >> 16) & 1u)) >> 16; }
__device__ __forceinline__ unsigned pk2(float lo, float hi) { return pg8::cvt_pk_bf16(lo, hi); }
__device__ __forceinline__ float bflo(unsigned w) { return __builtin_bit_cast(float, w << 16); }
__device__ __forceinline__ float bfhi(unsigned w) { return __builtin_bit_cast(float, w & 0xffff0000u); }
__device__ __forceinline__ float wave_sum(float v) {
#pragma unroll
    for (int o = 1; o < 64; o <<= 1) v += __shfl_xor(v, o);
    return v;
}
#define LDS_WAIT() asm volatile("s_waitcnt lgkmcnt(0)" ::: "memory")

template <int MODE>
__device__ __forceinline__ void p0_transpose_item(const float* W, int K, int N, bf16* WT, const float* kscale, LAS float* scr, int item, int lane) {
    const int nblk = N / 32, kb = item / nblk, nb = item % nblk, k0 = 64 * kb, n0 = 32 * nb;
#pragma unroll 8
    for (int i = 0; i < 32; ++i) { const int kk = 2 * i + (lane >> 5); float v = W[(size_t)(k0 + kk) * N + n0 + (lane & 31)]; if (kscale) v *= kscale[k0 + kk]; scr[kk * 33 + (lane & 31)] = v; }
    LDS_WAIT(); asm volatile("" ::: "memory");
    const int c = lane & 7;
#pragma unroll
    for (int j = 0; j < 4; ++j) { const int n = (lane >> 3) + 8 * j; const LAS float* s = scr + (8 * c) * 33 + n;
        v4u o; o.x = pk2(s[0 * 33], s[1 * 33]); o.y = pk2(s[2 * 33], s[3 * 33]); o.z = pk2(s[4 * 33], s[5 * 33]); o.w = pk2(s[6 * 33], s[7 * 33]);
        const int nn = n0 + n; const int drow = MODE == 0 ? nn : ((nn >> 7) * 256 + (MODE - 1) * 128 + (nn & 127));
        *(v4u*)(WT + (size_t)drow * K + k0 + 8 * c) = o; }
    LDS_WAIT(); asm volatile("" ::: "memory");
}

__device__ __forceinline__ void rms_row_to_bf16(const float* xrow, const float* g, bf16* orow, int lane) {
    const f32x4* xr = (const f32x4*)xrow + lane; const f32x4* gr = (const f32x4*)g + lane;
    f32x4 v[8]; float s = 0.f;
#pragma unroll
    for (int j = 0; j < 8; ++j) { v[j] = xr[64 * j]; s += (v[j].x * v[j].x + v[j].y * v[j].y) + (v[j].z * v[j].z + v[j].w * v[j].w); }
    const float rs = rsqrtf(wave_sum(s) * (1.0f / 2048.0f) + EPS);
    v2u* o8 = (v2u*)orow + lane;
#pragma unroll
    for (int j = 0; j < 8; ++j) { const f32x4 gg = gr[64 * j]; v2u o; o.x = pk2(v[j].x * rs * gg.x, v[j].y * rs * gg.y); o.y = pk2(v[j].z * rs * gg.z, v[j].w * rs * gg.w); o8[64 * j] = o; }
}

constexpr int KS_PITCH = 144, VT_PITCH = 560, KS_BYTES = 272 * KS_PITCH, VT_OFF = KS_BYTES;

__device__ __forceinline__ void attn_job(const LAS unsigned char* Ks, const LAS unsigned char* Vt, const bf16* qptr, float slope, float sink,
                                         int qpos, int jt0, int keymin, bf16* optr, int lane) {
    const int c = lane & 15, g = lane >> 4;
    bf16x8 qf[2];
#pragma unroll
    for (int ks = 0; ks < 2; ++ks) qf[ks] = *(const bf16x8*)(qptr + 32 * ks + 8 * g);
    f32x4 o[4];
#pragma unroll
    for (int dt = 0; dt < 4; ++dt) o[dt] = (f32x4){0.f, 0.f, 0.f, 0.f};
    float mx = sink, sum = 0.f;
#pragma unroll 1
    for (int s = 0; s < 5; ++s) {
        const int jt = jt0 + 2 * s;
        f32x4 st[2];
#pragma unroll
        for (int t = 0; t < 2; ++t) {
            f32x4 a = (f32x4){0.f, 0.f, 0.f, 0.f};
#pragma unroll
            for (int ks = 0; ks < 2; ++ks) {
                const bf16x8 kf = *(const LAS bf16x8*)(Ks + (16 * (jt + t) + c) * KS_PITCH + (32 * ks + 8 * g) * 2);
                a = __builtin_amdgcn_mfma_f32_16x16x32_bf16(kf, qf[ks], a, 0, 0, 0);
            }
            st[t] = a;
        }
        float lm = -1e30f;
#pragma unroll
        for (int t = 0; t < 2; ++t)
#pragma unroll
            for (int i = 0; i < 4; ++i) {
                const int key = 16 * (jt + t) + 4 * g + i, dist = qpos - key;
                const bool valid = dist >= 0 && dist <= 128 && key >= keymin;
                const float sc = valid ? st[t][i] * 0.125f - slope * (float)dist : -1e30f;
                st[t][i] = sc; lm = fmaxf(lm, sc);
            }
        lm = fmaxf(lm, __shfl_xor(lm, 16)); lm = fmaxf(lm, __shfl_xor(lm, 32));
        const float mn = fmaxf(mx, lm), alpha = __expf(mx - mn);
        mx = mn; sum *= alpha;
#pragma unroll
        for (int dt = 0; dt < 4; ++dt) o[dt] = o[dt] * alpha;
#pragma unroll
        for (int t = 0; t < 2; ++t)
#pragma unroll
            for (int i = 0; i < 4; ++i) { const float p = __expf(st[t][i] - mn); st[t][i] = p; sum += p; }
        v4u pw; pw.x = pk2(st[0][0], st[0][1]); pw.y = pk2(st[0][2], st[0][3]); pw.z = pk2(st[1][0], st[1][1]); pw.w = pk2(st[1][2], st[1][3]);
        const bf16x8 pb = __builtin_bit_cast(bf16x8, pw);
#pragma unroll
        for (int dt = 0; dt < 4; ++dt) {
            const LAS unsigned char* vp = Vt + (16 * dt + c) * VT_PITCH + (16 * jt + 4 * g) * 2;
            const v2u lo = *(const LAS v2u*)vp, hi = *(const LAS v2u*)(vp + 32);
            v4u vw; vw.x = lo.x; vw.y = lo.y; vw.z = hi.x; vw.w = hi.y;
            o[dt] = __builtin_amdgcn_mfma_f32_16x16x32_bf16(__builtin_bit_cast(bf16x8, vw), pb, o[dt], 0, 0, 0);
        }
    }
    sum += __shfl_xor(sum, 16); sum += __shfl_xor(sum, 32); sum += __expf(sink - mx);
    const float inv = 1.0f / sum;
#pragma unroll
    for (int dt = 0; dt < 4; ++dt) { v2u w; w.x = pk2(o[dt][0] * inv, o[dt][1] * inv); w.y = pk2(o[dt][2] * inv, o[dt][3] * inv); *(v2u*)(optr + 16 * dt + 4 * g) = w; }
}

__device__ __forceinline__ void attn_phase(const Args& a, LAS unsigned char* lds, int tid, int lane, int wave) {
    const bf16* QKV = (const bf16*)(a.ws + WS_QKV); bf16* ATT = (bf16*)(a.ws + WS_ATT);
    const float* cache_k = a.in[2]; const float* cache_v = a.in[3]; const float* sinks = a.in[8];
    float* out = a.out;
    LAS unsigned char* Ks = lds; LAS unsigned char* Vt = lds + VT_OFF;
    const int c = lane & 15;
    for (int unit = blockIdx.x; unit < 768; unit += gridDim.x) {
        __syncthreads();
        if (unit < 256) {
            const int b = unit >> 6, nb = (unit >> 2) & 15, kvh = unit & 3;
#pragma unroll 1
            for (int ch = tid; ch < 272 * 8; ch += NTHR) {
                const int j = ch >> 3, part = ch & 7, tok = (nb - 1) * 128 + j;
                v4u kk = (v4u){0u, 0u, 0u, 0u}, vv = (v4u){0u, 0u, 0u, 0u};
                if (j < 256 && tok >= 0) {
                    const bf16* src = QKV + (size_t)(b * SEQ + tok) * NIN + QK_OFF + kvh * 64 + part * 8;
                    kk = *(const v4u*)src; vv = *(const v4u*)(src + 256);
                    if (nb == 15 && j >= 128) {
                        float* ko = out + O_KWP + ((size_t)(b * 128 + j - 128) * 4 + kvh) * 64 + part * 8; float* vo = out + O_VWP + ((size_t)(b * 128 + j - 128) * 4 + kvh) * 64 + part * 8;
                        *(f32x4*)ko = (f32x4){bflo(kk.x), bfhi(kk.x), bflo(kk.y), bfhi(kk.y)}; *(f32x4*)(ko + 4) = (f32x4){bflo(kk.z), bfhi(kk.z), bflo(kk.w), bfhi(kk.w)};
                        *(f32x4*)vo = (f32x4){bflo(vv.x), bfhi(vv.x), bflo(vv.y), bfhi(vv.y)}; *(f32x4*)(vo + 4) = (f32x4){bflo(vv.z), bfhi(vv.z), bflo(vv.w), bfhi(vv.w)};
                    }
                }
                *(LAS v4u*)(Ks + j * KS_PITCH + part * 16) = kk;
                LAS unsigned short* vt = (LAS unsigned short*)(Vt + (part * 8) * VT_PITCH + j * 2);
                vt[0 * (VT_PITCH / 2)] = (unsigned short)(vv.x & 0xffffu); vt[1 * (VT_PITCH / 2)] = (unsigned short)(vv.x >> 16);
                vt[2 * (VT_PITCH / 2)] = (unsigned short)(vv.y & 0xffffu); vt[3 * (VT_PITCH / 2)] = (unsigned short)(vv.y >> 16);
                vt[4 * (VT_PITCH / 2)] = (unsigned short)(vv.z & 0xffffu); vt[5 * (VT_PITCH / 2)] = (unsigned short)(vv.z >> 16);
                vt[6 * (VT_PITCH / 2)] = (unsigned short)(vv.w & 0xffffu); vt[7 * (VT_PITCH / 2)] = (unsigned short)(vv.w >> 16);
            }
            __syncthreads();
            const int rt = wave;
            const size_t qrow = (size_t)(b * SEQ + nb * 128 + 16 * rt + c);
#pragma unroll 1
            for (int hq = 0; hq < 4; ++hq) {
                const int h = kvh * 4 + hq;
                const float slope = exp2f(-0.5f * (float)(h + 1)), sink = sinks[h];
                attn_job(Ks, Vt, QKV + qrow * NIN + h * 64, slope, sink, 16 * rt + c + 128, rt, nb > 0 ? 0 : 128, ATT + qrow * 1024 + h * 64, lane);
            }
        } else {
            const int su = unit - 256, b = su >> 2, kvh = su & 3;
#pragma unroll 1
            for (int ch = tid; ch < 160 * 8; ch += NTHR) {
                const int j = ch >> 3, part = ch & 7;
                v4u kk = (v4u){0u, 0u, 0u, 0u}, vv = (v4u){0u, 0u, 0u, 0u};
                if (j < 128) {
                    const size_t off = ((size_t)(b * 128 + j) * 4 + kvh) * 64 + part * 8;
                    const f32x4 k0 = *(const f32x4*)(cache_k + off), k1 = *(const f32x4*)(cache_k + off + 4), v0 = *(const f32x4*)(cache_v + off), v1 = *(const f32x4*)(cache_v + off + 4);
                    kk.x = pk2(k0.x, k0.y); kk.y = pk2(k0.z, k0.w); kk.z = pk2(k1.x, k1.y); kk.w = pk2(k1.z, k1.w);
                    vv.x = pk2(v0.x, v0.y); vv.y = pk2(v0.z, v0.w); vv.z = pk2(v1.x, v1.y); vv.w = pk2(v1.z, v1.w);
                    if (j >= 8) { const size_t oo = ((size_t)(b * 128 + j - 8) * 4 + kvh) * 64 + part * 8;
                        *(f32x4*)(out + O_KWS + oo) = k0; *(f32x4*)(out + O_KWS + oo + 4) = k1; *(f32x4*)(out + O_VWS + oo) = v0; *(f32x4*)(out + O_VWS + oo + 4) = v1; }
                } else if (j < 136) {
                    const bf16* src = QKV + (size_t)(MP + b * 8 + j - 128) * NIN + QK_OFF + kvh * 64 + part * 8;
                    kk = *(const v4u*)src; vv = *(const v4u*)(src + 256);
                    const size_t oo = ((size_t)(b * 128 + j - 8) * 4 + kvh) * 64 + part * 8;
                    float* ko = out + O_KWS + oo; float* vo = out + O_VWS + oo;
                    *(f32x4*)ko = (f32x4){bflo(kk.x), bfhi(kk.x), bflo(kk.y), bfhi(kk.y)}; *(f32x4*)(ko + 4) = (f32x4){bflo(kk.z), bfhi(kk.z), bflo(kk.w), bfhi(kk.w)};
                    *(f32x4*)vo = (f32x4){bflo(vv.x), bfhi(vv.x), bflo(vv.y), bfhi(vv.y)}; *(f32x4*)(vo + 4) = (f32x4){bflo(vv.z), bfhi(vv.z), bflo(vv.w), bfhi(vv.w)};
                }
                *(LAS v4u*)(Ks + j * KS_PITCH + part * 16) = kk;
                LAS unsigned short* vt = (LAS unsigned short*)(Vt + (part * 8) * VT_PITCH + j * 2);
                vt[0 * (VT_PITCH / 2)] = (unsigned short)(vv.x & 0xffffu); vt[1 * (VT_PITCH / 2)] = (unsigned short)(vv.x >> 16);
                vt[2 * (VT_PITCH / 2)] = (unsigned short)(vv.y & 0xffffu); vt[3 * (VT_PITCH / 2)] = (unsigned short)(vv.y >> 16);
                vt[4 * (VT_PITCH / 2)] = (unsigned short)(vv.z & 0xffffu); vt[5 * (VT_PITCH / 2)] = (unsigned short)(vv.z >> 16);
                vt[6 * (VT_PITCH / 2)] = (unsigned short)(vv.w & 0xffffu); vt[7 * (VT_PITCH / 2)] = (unsigned short)(vv.w >> 16);
            }
            __syncthreads();
            if (wave < 2) {
                const int qi = c & 7, h = kvh * 4 + 2 * wave + (c >> 3);
                const float slope = exp2f(-0.5f * (float)(h + 1)), sink = sinks[h];
                const size_t qrow = (size_t)(MP + b * 8 + qi);
                attn_job(Ks, Vt, QKV + qrow * NIN + h * 64, slope, sink, qi + 128, 0, 0, ATT + qrow * 1024 + h * 64, lane);
            }
        }
    }
}

__device__ __forceinline__ void load16bf(const bf16* p, float (&f)[16]) {
    const v4u a = *(const v4u*)p, b = *(const v4u*)(p + 8);
    f[0] = bflo(a.x); f[1] = bfhi(a.x); f[2] = bflo(a.y); f[3] = bfhi(a.y); f[4] = bflo(a.z); f[5] = bfhi(a.z); f[6] = bflo(a.w); f[7] = bfhi(a.w);
    f[8] = bflo(b.x); f[9] = bfhi(b.x); f[10] = bflo(b.y); f[11] = bfhi(b.y); f[12] = bflo(b.z); f[13] = bfhi(b.z); f[14] = bflo(b.w); f[15] = bfhi(b.w);
}
__device__ __forceinline__ void store16bf(bf16* p, const float (&f)[16]) {
    v4u a, b; a.x = pk2(f[0], f[1]); a.y = pk2(f[2], f[3]); a.z = pk2(f[4], f[5]); a.w = pk2(f[6], f[7]); b.x = pk2(f[8], f[9]); b.y = pk2(f[10], f[11]); b.z = pk2(f[12], f[13]); b.w = pk2(f[14], f[15]);
    *(v4u*)p = a; *(v4u*)(p + 8) = b;
}
__device__ __forceinline__ void load16f(const float* p, float (&f)[16]) {
#pragma unroll
    for (int q = 0; q < 4; ++q) { const f32x4 v = *(const f32x4*)(p + 4 * q); f[4 * q] = v.x; f[4 * q + 1] = v.y; f[4 * q + 2] = v.z; f[4 * q + 3] = v.w; }
}
__device__ __forceinline__ void store16f(float* p, const float (&f)[16]) {
#pragma unroll
    for (int q = 0; q < 4; ++q) *(f32x4*)(p + 4 * q) = (f32x4){f[4 * q], f[4 * q + 1], f[4 * q + 2], f[4 * q + 3]};
}
__device__ __forceinline__ void mix_row(const Args& a, int r, int lane) {
    const bf16* QKV = (const bf16*)(a.ws + WS_QKV); const bf16* ATT = (const bf16*)(a.ws + WS_ATT); bf16* MIX = (bf16*)(a.ws + WS_MIX);
    const float* state_conv = a.in[4]; const float* conv_w = a.in[9]; const float* gA = a.in[10]; const float* gB = a.in[11];
    const int c0 = lane * 16;
    float x[16], gg[16];
    load16bf(ATT + (size_t)r * 1024 + c0, x);
    float s = 0.f;
#pragma unroll
    for (int e = 0; e < 16; ++e) s += x[e] * x[e];
    float rs = rsqrtf(wave_sum(s) * (1.0f / 1024.0f) + EPS);
    load16f(gA + c0, gg);
#pragma unroll
    for (int e = 0; e < 16; ++e) x[e] = x[e] * rs * gg[e];
    store16bf(MIX + (size_t)r * 2048 + c0, x);
    float Bv[16], Cv[16], Uv[16], cu[16], p1[16], p2[16], w0[16], w1[16], w2[16];
    const bf16* qr = QKV + (size_t)r * NIN;
    load16bf(qr + QB_OFF + c0, Bv); load16bf(qr + QC_OFF + c0, Cv); load16bf(qr + QU_OFF + c0, Uv);
#pragma unroll
    for (int e = 0; e < 16; ++e) { cu[e] = Cv[e] * Uv[e]; p1[e] = 0.f; p2[e] = 0.f; }
    int t, nseq; float* cs_out;
    if (r < MP) { t = r & (SEQ - 1); nseq = SEQ; cs_out = a.out + O_CVP + (size_t)((r >> 11) * 2) * 1024 + c0; }
    else { t = (r - MP) & 7; nseq = 8; cs_out = a.out + O_CVS + (size_t)(((r - MP) >> 3) * 2) * 1024 + c0; }
    if (t >= 1) { load16bf(qr - NIN + QC_OFF + c0, Cv); load16bf(qr - NIN + QU_OFF + c0, Uv);
#pragma unroll
        for (int e = 0; e < 16; ++e) p1[e] = Cv[e] * Uv[e]; }
    else if (r >= MP) load16f(state_conv + (size_t)(((r - MP) >> 3) * 2 + 1) * 1024 + c0, p1);
    if (t >= 2) { load16bf(qr - 2 * NIN + QC_OFF + c0, Cv); load16bf(qr - 2 * NIN + QU_OFF + c0, Uv);
#pragma unroll
        for (int e = 0; e < 16; ++e) p2[e] = Cv[e] * Uv[e]; }
    else if (r >= MP) load16f(state_conv + (size_t)(((r - MP) >> 3) * 2 + t) * 1024 + c0, p2);
    if (t >= nseq - 2) store16f(cs_out + (size_t)(t - (nseq - 2)) * 1024, cu);
    load16f(conv_w + c0, w0); load16f(conv_w + 1024 + c0, w1); load16f(conv_w + 2048 + c0, w2);
    s = 0.f;
#pragma unroll
    for (int e = 0; e < 16; ++e) { x[e] = Bv[e] * (w0[e] * p2[e] + w1[e] * p1[e] + w2[e] * cu[e]); s += x[e] * x[e]; }
    rs = rsqrtf(wave_sum(s) * (1.0f / 1024.0f) + EPS);
    load16f(gB + c0, gg);
#pragma unroll
    for (int e = 0; e < 16; ++e) x[e] = x[e] * rs * gg[e];
    store16bf(MIX + (size_t)r * 2048 + 1024 + c0, x);
}

__device__ __forceinline__ void fixup_phase(const Args& a, int gtid, int gthreads) {
    const float* SG = (const float*)(a.ws + WS_SG); const float* SU = (const float*)(a.ws + WS_SU); const float* TG = (const float*)(a.ws + WS_TG);
    const float* cw = a.in[16]; const float* cb = a.in[17]; bf16* HM = (bf16*)(a.ws + WS_HM);
    constexpr int C4 = DFF / 4;
    for (int it = gtid; it < 128 * 2 * C4; it += gthreads) {
        const int c = (it % C4) * 4, bi = it / C4, i = bi & 1, blk = bi >> 1;
        const bool start = (blk & 31) == 0;
        const f32x4 z = (f32x4){0.f, 0.f, 0.f, 0.f};
        const f32x4 g0 = *(const f32x4*)(SG + (size_t)(blk * 2 + i) * DFF + c), u0 = *(const f32x4*)(SU + (size_t)(blk * 2 + i) * DFF + c);
        f32x4 p1, p2;
        if (i == 0) { p1 = start ? z : *(const f32x4*)(TG + (size_t)((blk - 1) * 2 + 1) * DFF + c); p2 = start ? z : *(const f32x4*)(TG + (size_t)((blk - 1) * 2) * DFF + c); }
        else { p1 = *(const f32x4*)(SG + (size_t)(blk * 2) * DFF + c); p2 = start ? z : *(const f32x4*)(TG + (size_t)((blk - 1) * 2 + 1) * DFF + c); }
        const f32x4 w0 = *(const f32x4*)(cw + c), w1 = *(const f32x4*)(cw + DFF + c), w2 = *(const f32x4*)(cw + 2 * DFF + c), bb = *(const f32x4*)(cb + c);
        float h[4];
#pragma unroll
        for (int e = 0; e < 4; ++e) { const float av = w0[e] * p2[e] + w1[e] * p1[e] + w2[e] * g0[e] + bb[e]; h[e] = pg8::silu_f(av) * u0[e]; }
        v2u w; w.x = pk2(h[0], h[1]); w.y = pk2(h[2], h[3]);
        *(v2u*)(HM + (size_t)(blk * 64 + i) * DFF + c) = w;
    }
}

__device__ __forceinline__ void final_row(float* row, const float* g, int lane) {
    f32x4* xr = (f32x4*)row + lane; const f32x4* gr = (const f32x4*)g + lane;
    f32x4 v[8]; float s = 0.f;
#pragma unroll
    for (int j = 0; j < 8; ++j) { v[j] = xr[64 * j]; s += (v[j].x * v[j].x + v[j].y * v[j].y) + (v[j].z * v[j].z + v[j].w * v[j].w); }
    const float rs = rsqrtf(wave_sum(s) * (1.0f / 2048.0f) + EPS);
#pragma unroll
    for (int j = 0; j < 8; ++j) { const f32x4 gg = gr[64 * j]; xr[64 * j] = (f32x4){v[j].x * rs * gg.x, v[j].y * rs * gg.y, v[j].z * rs * gg.z, v[j].w * rs * gg.w}; }
}

#ifndef ONE_LAUNCH
#define ONE_LAUNCH 1
#endif
constexpr int NPHASE = 9;

__global__ void __launch_bounds__(NTHR, 2) hymba_fwd(Args a) {
    extern __shared__ __attribute__((aligned(16))) unsigned char lds_raw[];
    LAS unsigned char* lds = (LAS unsigned char*)lds_raw;
    cg::grid_group grid = cg::this_grid();
    const int tid = threadIdx.x, lane = tid & 63, wave = __builtin_amdgcn_readfirstlane(tid >> 6);
    const int G = gridDim.x, bx = blockIdx.x;
    const int vcu = (G % 8 == 0) ? (bx % 8) * (G / 8) + bx / 8 : bx;
    const int gw = vcu * NWAVES + wave, NGW = G * NWAVES;
    const int lo = a.ph_lo, hi = a.ph_hi;
    unsigned char* ws = a.ws;
#ifndef PHMASK
#define PHMASK 0x1ff
#endif
#define IN(k) (((PHMASK >> (k)) & 1) && lo <= (k) && (k) < hi)
#define SEAM(k) do { if (IN(k) && IN((k) + 1)) grid.sync(); } while (0)

    if (IN(0)) {
        LAS float* scr = (LAS float*)(lds + wave * 16384);
        constexpr int I_IN = (DM / 64) * (NIN / 32), I_OUT = (DM / 64) * (DM / 32), I_G = (DM / 64) * (DFF / 32), I_DN = (DFF / 64) * (DM / 32);
        constexpr int NITEMS = I_IN + I_OUT + 2 * I_G + I_DN;
        for (int it = gw; it < NITEMS; it += NGW) {
            int r = it;
            if (r < I_IN) { p0_transpose_item<0>(a.in[7], DM, NIN, (bf16*)(ws + WS_WIN), nullptr, scr, r, lane); continue; } r -= I_IN;
            if (r < I_OUT) { p0_transpose_item<0>(a.in[12], DM, DM, (bf16*)(ws + WS_WOUT), nullptr, scr, r, lane); continue; } r -= I_OUT;
            if (r < I_G) { p0_transpose_item<1>(a.in[14], DM, DFF, (bf16*)(ws + WS_WGU), a.in[13], scr, r, lane); continue; } r -= I_G;
            if (r < I_G) { p0_transpose_item<2>(a.in[15], DM, DFF, (bf16*)(ws + WS_WGU), a.in[13], scr, r, lane); continue; } r -= I_G;
            p0_transpose_item<0>(a.in[18], DFF, DM, (bf16*)(ws + WS_WDN), nullptr, scr, r, lane);
        }
        for (int m = gw; m < MT; m += NGW) {
            const float* xrow = m < MP ? a.in[0] + (size_t)m * DM : a.in[1] + (size_t)(m - MP) * DM;
            rms_row_to_bf16(xrow, a.in[6], (bf16*)(ws + WS_H) + (size_t)m * DM, lane);
        }
        for (int i = bx * NTHR + tid; i < MT; i += G * NTHR) ((float*)(ws + WS_SS1))[i] = 0.f;
    }
    SEAM(0);
    if (IN(1)) {
        __syncthreads();
        pg8::Gemm g{(const pg8::bf16_t*)(ws + WS_H), (const pg8::bf16_t*)(ws + WS_WIN), MT, NIN, DM}; pg8::StaticOrder S; S.init(MT, NIN, G, bx);
        pg8::EpiBf16<0> E{(pg8::bf16_t*)(ws + WS_QKV), NIN, nullptr, 0, 0, 1.f};
        pg8::gemm_phase<pg8::EpiBf16<0>, pg8::StaticOrder, true, true>(lds, g, S, E);
    }
    SEAM(1);
    if (IN(2)) { __syncthreads(); attn_phase(a, lds, tid, lane, wave); }
    SEAM(2);
    if (IN(3)) { for (int m = gw; m < MT; m += NGW) mix_row(a, m, lane); }
    SEAM(3);
    if (IN(4)) {
        __syncthreads();
        pg8::Gemm g{(const pg8::bf16_t*)(ws + WS_MIX), (const pg8::bf16_t*)(ws + WS_WOUT), MT, DM, DM}; pg8::StaticOrder S; S.init(MT, DM, G, bx);
        pg8::EpiRes E{a.in[0], a.in[1], a.out + O_Y, (pg8::bf16_t*)(ws + WS_H), (float*)(ws + WS_SS1)};
        pg8::gemm_phase<pg8::EpiRes, pg8::StaticOrder, true, true>(lds, g, S, E);
    }
    SEAM(4);
    if (IN(5)) {
        __syncthreads();
        pg8::Gemm g{(const pg8::bf16_t*)(ws + WS_H), (const pg8::bf16_t*)(ws + WS_WGU), MT, 2 * DFF, DM}; pg8::StaticOrder S; S.init(MT, 2 * DFF, G, bx);
        pg8::EpiGU E{(pg8::bf16_t*)(ws + WS_HM), (const float*)(ws + WS_SS1), a.in[16], a.in[17], a.in[5],
                     (float*)(ws + WS_SG), (float*)(ws + WS_SU), (float*)(ws + WS_TG), a.out + O_FFP, a.out + O_FFS};
        pg8::gemm_phase<pg8::EpiGU, pg8::StaticOrder, true, true>(lds, g, S, E);
    }
    SEAM(5);
    if (IN(6)) fixup_phase(a, bx * NTHR + tid, G * NTHR);
    SEAM(6);
    if (IN(7)) {
        __syncthreads();
        pg8::Gemm g{(const pg8::bf16_t*)(ws + WS_HM), (const pg8::bf16_t*)(ws + WS_WDN), MT, DM, DFF}; pg8::StaticOrder S; S.init(MT, DM, G, bx);
        pg8::EpiRes E{a.out + O_Y, a.out + O_Y + (size_t)MP * DM, a.out + O_Y, nullptr, nullptr};
        pg8::gemm_phase<pg8::EpiRes, pg8::StaticOrder, true, true>(lds, g, S, E);
    }
    SEAM(7);
    if (IN(8)) { for (int m = gw; m < MT; m += NGW) final_row(a.out + O_Y + (size_t)m * DM, a.in[19], lane); }
#undef IN
#undef SEAM
}

extern "C" void kernel_launch(void* const* d_in, const int* in_sizes, int n_in, void* d_out, int out_size, void* d_ws, size_t ws_size, hipStream_t stream) {
    static int grid = 0;
    if (grid == 0) {
        if (n_in != 20 || out_size != (int)O_END || ws_size < WS_END) { fprintf(stderr, "kernel_launch: unexpected shapes (n_in %d, out %d, ws %zu)\n", n_in, out_size, ws_size); grid = -1; return; }
        int dev = 0, cus = 0, per_cu = 0;
        (void)hipGetDevice(&dev); (void)hipDeviceGetAttribute(&cus, hipDeviceAttributeMultiprocessorCount, dev);
        if (hipFuncSetAttribute((const void*)hymba_fwd, hipFuncAttributeMaxDynamicSharedMemorySize, LDS_BYTES) != hipSuccess) { fprintf(stderr, "kernel_launch: hipFuncSetAttribute failed\n"); grid = -1; return; }
        if (hipOccupancyMaxActiveBlocksPerMultiprocessor(&per_cu, (const void*)hymba_fwd, NTHR, LDS_BYTES) != hipSuccess || per_cu < 1) { fprintf(stderr, "kernel_launch: occupancy query says %d\n", per_cu); per_cu = 1; }
        (void)hipGetLastError();
        grid = cus * per_cu;
        fprintf(stderr, "kernel_launch: grid %d (cus %d x %d)\n", grid, cus, per_cu);
    }
    if (grid < 0) return;
    Args a{};
    for (int i = 0; i < 20; ++i) a.in[i] = (const float*)d_in[i];
    a.out = (float*)d_out; a.ws = (unsigned char*)d_ws;
#if ONE_LAUNCH
    a.ph_lo = 0; a.ph_hi = NPHASE;
    void* args[] = {&a};
    hipError_t e = hipLaunchCooperativeKernel((const void*)hymba_fwd, dim3(grid), dim3(NTHR), args, LDS_BYTES, stream);
    if (e != hipSuccess) fprintf(stderr, "kernel_launch: cooperative launch failed: %s (grid %d)\n", hipGetErrorString(e), grid);
#else
    for (int p = 0; p < NPHASE; ++p) {
        a.ph_lo = p; a.ph_hi = p + 1;
        hipLaunchKernelGGL(hymba_fwd, dim3(grid), dim3(NTHR), LDS_BYTES, stream, a);
    }
#endif
}
```

```cpp
#include <hip/hip_runtime.h>
#include <hip/hip_cooperative_groups.h>
#include <cstdio>
#include <cstdint>
namespace cg = cooperative_groups;
namespace pg8 {
#define PG8_LAS __attribute__((address_space(3)))
typedef unsigned short bf16_t;
typedef short bf16x8 __attribute__((ext_vector_type(8)));
typedef float f32x4 __attribute__((ext_vector_type(4)));
typedef unsigned u32x4 __attribute__((ext_vector_type(4)));
constexpr int BM = 256, BK = 64, HALF = 128, HTB = HALF * BK * 2  , STAGE_BYTES = 8 * HTB, NXCD = 8, WGM = 8;

__host__ __device__ __forceinline__ int lds_byte(int r, int c) { const int st = (r >> 4) * 2 + (c >> 5), rr = r & 15, cc = c & 31, ob = rr * 64 + cc * 2; return st * 1024 + (ob ^ (((ob >> 9) & 1) << 5)); }
__host__ __device__ __forceinline__ void stage_rc(int b, int& R, int& C) { const int st = b / 1024, sb = b % 1024, swz = sb ^ (((sb >> 9) & 1) << 5); R = (st >> 1) * 16 + swz / 64; C = (st & 1) * 32 + (swz % 64) / 2; }
__host__ __device__ __forceinline__ int perm32(int rho) { const int n = rho >> 4, i = rho & 15; return 8 * (i >> 2) + 4 * n + (i & 3); }

struct Unit { int pm, pn; };
struct Gemm { const bf16_t* A; const bf16_t* Bt; int M, N, K; };

struct StaticOrder {
    int nM, nN, nwg, G, c;
    __host__ __device__ void init(int M, int N, int G_, int c_) { nM = M / BM; nN = N / BM; nwg = nM * nN; G = G_; c = c_; }
    __host__ __device__ bool next(int i, Unit& u) const {
        const long L = (long)i * G + c; if (L >= nwg) return false;
        int wgid = (int)L; { const int q = nwg / NXCD, r = nwg % NXCD, xcd = wgid % NXCD, off = wgid / NXCD; wgid = (xcd < r ? xcd * (q + 1) : r * (q + 1) + (xcd - r) * q) + off; }
        const int nig = WGM * nN, gid = wgid / nig, fm = gid * WGM, gsz = (nM - fm) < WGM ? (nM - fm) : WGM;
        u.pm = fm + ((wgid % nig) % gsz); u.pn = (wgid % nig) / gsz; return true;
    }
    __device__ __forceinline__ void a_ready(const Unit&) const {}
    __device__ __forceinline__ void done(const Unit&) const {}
};

__device__ __forceinline__ unsigned cvt_pk_bf16(float lo, float hi) { unsigned r; asm volatile("v_cvt_pk_bf16_f32 %0, %1, %2" : "=v"(r) : "v"(lo), "v"(hi)); return r; }
typedef float f32x2 __attribute__((ext_vector_type(2)));
__device__ __forceinline__ f32x2 gelu_pk(f32x2 v) {
    const f32x2 av = __builtin_elementwise_abs(v), d = av * 0.2316418882f + 1.0f;
    f32x2 t; t.x = __builtin_amdgcn_rcpf(d.x); t.y = __builtin_amdgcn_rcpf(d.y);
    f32x2 q = t * 0.5307027145f + (-0.7265760135f); q = q * t + 0.7107068705f; q = q * t + (-0.142248368f); q = q * t + 0.127414796f; q = q * t;
    const f32x2 s = (v * v) * (-0.72134752044f);
    f32x2 e; e.x = __builtin_amdgcn_exp2f(s.x); e.y = __builtin_amdgcn_exp2f(s.y);
    const f32x2 m = v * (q * e), r = v - m;
    f32x2 o; o.x = v.x < 0.f ? m.x : r.x; o.y = v.y < 0.f ? m.y : r.y; return o;
}

template <int ACT  > struct EpiBf16 {
    static constexpr bool PERM = true, AFTER_DRAIN = false; static_assert(ACT == 0 || ACT == 1, "EpiBf16: ACT is 0 (none) or 1 (gelu_pk)");
    bf16_t* O; int ldc; const float* bias; int split_cols; size_t split_stride; float scale0;
    __device__ __forceinline__ void operator()(const f32x4 (&acc)[2][2][4][2], const Unit& u, int wr, int wc, int fr, int fq) const {
        const int row0 = u.pm * BM + wr * 64 + fr; int colt = u.pn * BM; bf16_t* base = O;
        float sc = 1.f; if (split_cols) { const int t = colt / split_cols; base += (size_t)t * split_stride; colt -= t * split_cols; if (t == 0) sc = scale0; }
        const int col0 = colt + wc * 32 + 8 * fq, bcol0 = u.pn * BM + wc * 32 + 8 * fq;
        f32x4 bv[2][2];
#pragma unroll
        for (int bj = 0; bj < 2; ++bj)
#pragma unroll
            for (int n = 0; n < 2; ++n) bv[bj][n] = bias ? *(const f32x4*)(bias + bcol0 + bj * HALF + 4 * n) : (f32x4){0.f, 0.f, 0.f, 0.f};
#pragma unroll
        for (int ai = 0; ai < 2; ++ai)
#pragma unroll
            for (int m = 0; m < 4; ++m) { bf16_t* rowp = base + (size_t)(row0 + ai * HALF + m * 16) * ldc + col0;
#pragma unroll
                for (int bj = 0; bj < 2; ++bj) { f32x4 v0 = acc[ai][bj][m][0] + bv[bj][0], v1 = acc[ai][bj][m][1] + bv[bj][1];
                    if (ACT == 1) { f32x2 a = gelu_pk((f32x2){v0[0], v0[1]}), b = gelu_pk((f32x2){v0[2], v0[3]}), c = gelu_pk((f32x2){v1[0], v1[1]}), d = gelu_pk((f32x2){v1[2], v1[3]});
                        v0 = (f32x4){a.x, a.y, b.x, b.y}; v1 = (f32x4){c.x, c.y, d.x, d.y}; }
                    v0 = v0 * sc; v1 = v1 * sc; u32x4 w; w.x = cvt_pk_bf16(v0[0], v0[1]); w.y = cvt_pk_bf16(v0[2], v0[3]); w.z = cvt_pk_bf16(v1[0], v1[1]); w.w = cvt_pk_bf16(v1[2], v1[3]);
                    *(u32x4*)(rowp + bj * HALF) = w; } }
    }
};
template <class Epi, class Sched, bool ALIGN_EPI = false, bool SP2 = false>
__device__ __forceinline__ void gemm_phase(PG8_LAS unsigned char* lds, const Gemm g, const Sched& S, const Epi& E) {
    const int tid = threadIdx.x, wid = __builtin_amdgcn_readfirstlane(tid >> 6), lane = tid & 63, wr = wid >> 2, wc = wid & 3, fr = lane & 15, fq = lane >> 4;
    const int K = g.K, nt = K / BK;
    unsigned voffA[2], voffB[2];
#pragma unroll
    for (int i = 0; i < 2; ++i) { int R, C; stage_rc(tid * 16 + i * 8192, R, C); const int Rb = Epi::PERM ? ((R & ~31) + perm32(R & 31)) : R;
        voffA[i] = (unsigned)(R * K + C) * 2u; voffB[i] = (unsigned)(Rb * K + C) * 2u; }
    const size_t kstep = (size_t)(BK * 2);
    const size_t hstep = (size_t)HALF * K * 2;
    const size_t tstep = 2 * hstep;
    const unsigned ldsw = (unsigned)wid * 1024u;
    const int aoff = lds_byte(wr * 64 + fr, fq * 8), boff = lds_byte(wc * 32 + fr, fq * 8);
#define PG8_SA(b, h) (((b) * 2 + (h)) * HTB)
#define PG8_SB(b, h) ((4 + (b) * 2 + (h)) * HTB)
#define PG8_STAGE(bufoff, gbase, voff) do { _Pragma("unroll") for (int _i = 0; _i < 2; ++_i) \
        __builtin_amdgcn_global_load_lds((const unsigned*)((const char*)(gbase) + (voff)[_i]), (PG8_LAS unsigned*)(lds + (bufoff) + ldsw + _i * 8192), 16, 0, 0); } while (0)
#define PG8_LDA(dst, b, h) do { _Pragma("unroll") for (int m = 0; m < 4; ++m) _Pragma("unroll") for (int k = 0; k < 2; ++k) dst[m][k] = *(const PG8_LAS bf16x8*)(lds + PG8_SA(b, h) + aoff + m * 2048 + k * 1024); } while (0)
#define PG8_LDB(dst, b, h) do { _Pragma("unroll") for (int n = 0; n < 2; ++n) _Pragma("unroll") for (int k = 0; k < 2; ++k) dst[n][k] = *(const PG8_LAS bf16x8*)(lds + PG8_SB(b, h) + boff + n * 2048 + k * 1024); } while (0)
#define PG8_MMA(ai, bj, At, Bt) do { __builtin_amdgcn_s_setprio(1); _Pragma("unroll") for (int m = 0; m < 4; ++m) _Pragma("unroll") for (int n = 0; n < 2; ++n) _Pragma("unroll") for (int k = 0; k < 2; ++k) \
        acc[ai][bj][m][n] = __builtin_amdgcn_mfma_f32_16x16x32_bf16(Bt[n][k], At[m][k], acc[ai][bj][m][n], 0, 0, 0); __builtin_amdgcn_s_setprio(0); } while (0)
#define PG8_WAIT_V(n) asm volatile("s_waitcnt vmcnt(" #n ")" ::: "memory")
#define PG8_WAIT_L(n) asm volatile("s_waitcnt lgkmcnt(" #n ")" ::: "memory")
#define PG8_BAR __builtin_amdgcn_s_barrier()
#define PG8_SCHED __builtin_amdgcn_sched_barrier(0)
    Unit cur, nxt; int ui = 0;
    if (!S.next(0, cur)) return;
    f32x4 acc[2][2][4][2];
#pragma unroll
    for (int a = 0; a < 2; ++a)
#pragma unroll
        for (int b = 0; b < 2; ++b)
#pragma unroll
            for (int m = 0; m < 4; ++m)
#pragma unroll
                for (int n = 0; n < 2; ++n) acc[a][b][m][n] = (f32x4){0.f, 0.f, 0.f, 0.f};
    bf16x8 At[4][2], B0[2][2], B1[2][2];
    const char* cA = (const char*)g.A + (size_t)cur.pm * tstep; const char* cB = (const char*)g.Bt + (size_t)cur.pn * tstep;
    S.a_ready(cur);
    if constexpr (SP2) {
        PG8_STAGE(PG8_SB(0, 0), cB, voffB); PG8_STAGE(PG8_SB(0, 1), cB + hstep, voffB); PG8_STAGE(PG8_SA(0, 0), cA, voffA); PG8_STAGE(PG8_SA(0, 1), cA + hstep, voffA);
        if (wr == 1) PG8_BAR;
        PG8_WAIT_V(2); PG8_BAR;
        PG8_STAGE(PG8_SB(1, 0), cB + kstep, voffB); PG8_STAGE(PG8_SA(1, 0), cA + kstep, voffA); PG8_STAGE(PG8_SB(1, 1), cB + hstep + kstep, voffB);
        PG8_WAIT_V(6); PG8_BAR;
    } else {
        PG8_STAGE(PG8_SB(0, 0), cB, voffB); PG8_STAGE(PG8_SA(0, 0), cA, voffA); PG8_STAGE(PG8_SB(0, 1), cB + hstep, voffB); PG8_STAGE(PG8_SA(0, 1), cA + hstep, voffA);
        if (wr == 1) PG8_BAR;
        PG8_WAIT_V(4); PG8_BAR;
        PG8_STAGE(PG8_SB(1, 0), cB + kstep, voffB); PG8_STAGE(PG8_SA(1, 0), cA + kstep, voffA); PG8_STAGE(PG8_SB(1, 1), cB + hstep + kstep, voffB);
        PG8_WAIT_V(6); PG8_BAR;
    }
    for (;;) {
        const bool has_next = S.next(ui + 1, nxt);
        const char* nA = has_next ? (const char*)g.A + (size_t)nxt.pm * tstep : cA; const char* nB = has_next ? (const char*)g.Bt + (size_t)nxt.pn * tstep : cB;
        for (int t = 0; t < nt; t += 2) {
            const bool last = (t == nt - 2);
            const char* a1 = cA + (size_t)(t + 1) * kstep;
            const char* a2 = last ? nA : cA + (size_t)(t + 2) * kstep; const char* b2 = last ? nB : cB + (size_t)(t + 2) * kstep;
            const char* a3 = a2 + kstep; const char* b3 = b2 + kstep;
            if (last && has_next) S.a_ready(nxt);
            if constexpr (SP2) {
            PG8_LDB(B0, 0, 0); PG8_LDB(B1, 0, 1); PG8_SCHED; PG8_LDA(At, 0, 0); PG8_STAGE(PG8_SA(1, 1), a1 + hstep, voffA);
            PG8_WAIT_V(8); PG8_WAIT_L(0); PG8_BAR; PG8_MMA(0, 0, At, B0); PG8_MMA(0, 1, At, B1); PG8_BAR; PG8_SCHED;
            PG8_LDA(At, 0, 1); PG8_STAGE(PG8_SB(0, 0), b2, voffB); PG8_STAGE(PG8_SB(0, 1), b2 + hstep, voffB); PG8_STAGE(PG8_SA(0, 0), a2, voffA);
            PG8_WAIT_V(8); PG8_WAIT_L(0); PG8_BAR; PG8_MMA(1, 0, At, B0); PG8_MMA(1, 1, At, B1); PG8_BAR; PG8_SCHED;
            PG8_LDB(B0, 1, 0); PG8_LDB(B1, 1, 1); PG8_SCHED; PG8_LDA(At, 1, 0); PG8_STAGE(PG8_SA(0, 1), a2 + hstep, voffA);
            PG8_WAIT_V(8); PG8_WAIT_L(0); PG8_BAR; PG8_MMA(0, 0, At, B0); PG8_MMA(0, 1, At, B1); PG8_BAR; PG8_SCHED;
            PG8_LDA(At, 1, 1); PG8_STAGE(PG8_SB(1, 0), b3, voffB); PG8_STAGE(PG8_SB(1, 1), b3 + hstep, voffB); PG8_STAGE(PG8_SA(1, 0), a3, voffA);
            PG8_WAIT_V(8); PG8_WAIT_L(0); PG8_BAR; PG8_MMA(1, 0, At, B0); PG8_MMA(1, 1, At, B1); PG8_BAR; PG8_SCHED;
            } else {
            PG8_LDB(B0, 0, 0); PG8_SCHED; PG8_LDA(At, 0, 0); PG8_STAGE(PG8_SA(1, 1), a1 + hstep, voffA);
            PG8_WAIT_L(8); PG8_BAR; PG8_WAIT_L(0); PG8_MMA(0, 0, At, B0); PG8_BAR; PG8_SCHED;
            PG8_LDB(B1, 0, 1); PG8_STAGE(PG8_SB(0, 0), b2, voffB);
            PG8_BAR; PG8_WAIT_L(0); PG8_MMA(0, 1, At, B1); PG8_BAR;
            PG8_LDA(At, 0, 1); PG8_STAGE(PG8_SA(0, 0), a2, voffA);
            PG8_BAR; PG8_WAIT_L(0); PG8_MMA(1, 0, At, B0); PG8_BAR; PG8_SCHED;
            PG8_STAGE(PG8_SB(0, 1), b2 + hstep, voffB);
            PG8_WAIT_V(6); PG8_BAR; PG8_MMA(1, 1, At, B1); PG8_BAR;
            PG8_LDB(B0, 1, 0); PG8_SCHED; PG8_LDA(At, 1, 0); PG8_STAGE(PG8_SA(0, 1), a2 + hstep, voffA);
            PG8_WAIT_L(8); PG8_BAR; PG8_WAIT_L(0); PG8_MMA(0, 0, At, B0); PG8_BAR; PG8_SCHED;
            PG8_LDB(B1, 1, 1); PG8_STAGE(PG8_SB(1, 0), b3, voffB);
            PG8_BAR; PG8_WAIT_L(0); PG8_MMA(0, 1, At, B1); PG8_BAR;
            PG8_LDA(At, 1, 1); PG8_STAGE(PG8_SA(1, 0), a3, voffA);
            PG8_BAR; PG8_WAIT_L(0); PG8_MMA(1, 0, At, B0); PG8_BAR; PG8_SCHED;
            PG8_STAGE(PG8_SB(1, 1), b3 + hstep, voffB);
            PG8_WAIT_V(6); PG8_BAR; PG8_MMA(1, 1, At, B1); PG8_BAR;
            }
        }
        if constexpr (ALIGN_EPI) { if (wr == 0) PG8_BAR; }
        if constexpr (!Epi::AFTER_DRAIN) { E(acc, cur, wr, wc, fr, fq); S.done(cur); }
        if (!has_next) break;
#pragma unroll
        for (int a = 0; a < 2; ++a)
#pragma unroll
            for (int b = 0; b < 2; ++b)
#pragma unroll
                for (int m = 0; m < 4; ++m)
#pragma unroll
                    for (int n = 0; n < 2; ++n) acc[a][b][m][n] = (f32x4){0.f, 0.f, 0.f, 0.f};
        cur = nxt; cA = nA; cB = nB; ++ui;
        if constexpr (ALIGN_EPI) { if (wr == 1) PG8_BAR; }
    }
    PG8_WAIT_V(0);
    if constexpr (!ALIGN_EPI) { if (wr == 0) PG8_BAR; }
    PG8_BAR;
    if constexpr (Epi::AFTER_DRAIN) { E.fused(acc, cur, wr, wc, fr, fq, lds, wid, lane); S.done(cur); }
#undef PG8_SA
#undef PG8_SB
#undef PG8_STAGE
#undef PG8_LDA
#undef PG8_LDB
#undef PG8_MMA
#undef PG8_WAIT_V
#undef PG8_WAIT_L
#undef PG8_BAR
#undef PG8_SCHED
}
}

namespace pg8 {
struct EpiRes {
    static constexpr bool PERM = true, AFTER_DRAIN = false;
    const float* xp; const float* xs; float* out; bf16_t* xb; float* ss;
    __device__ __forceinline__ void operator()(const f32x4 (&acc)[2][2][4][2], const Unit& u, int wr, int wc, int fr, int fq) const {
#pragma unroll
        for (int ai = 0; ai < 2; ++ai)
#pragma unroll
            for (int m = 0; m < 4; ++m) {
                const int row = u.pm * BM + ai * HALF + wr * 64 + m * 16 + fr;
                const float* src = row < 8192 ? xp + (size_t)row * 2048 : xs + (size_t)(row - 8192) * 2048;
                float s = 0.f;
#pragma unroll
                for (int bj = 0; bj < 2; ++bj) {
                    const int col = u.pn * BM + bj * HALF + wc * 32 + 8 * fq;
                    const f32x4 a0 = *(const f32x4*)(src + col), a1 = *(const f32x4*)(src + col + 4);
                    const f32x4 v0 = acc[ai][bj][m][0] + a0, v1 = acc[ai][bj][m][1] + a1;
                    *(f32x4*)(out + (size_t)row * 2048 + col) = v0; *(f32x4*)(out + (size_t)row * 2048 + col + 4) = v1;
                    if (xb) { u32x4 w; w.x = cvt_pk_bf16(v0[0], v0[1]); w.y = cvt_pk_bf16(v0[2], v0[3]); w.z = cvt_pk_bf16(v1[0], v1[1]); w.w = cvt_pk_bf16(v1[2], v1[3]);
                        *(u32x4*)(xb + (size_t)row * 2048 + col) = w; }
                    s += (v0[0] * v0[0] + v0[1] * v0[1]) + (v0[2] * v0[2] + v0[3] * v0[3]) + (v1[0] * v1[0] + v1[1] * v1[1]) + (v1[2] * v1[2] + v1[3] * v1[3]);
                }
                if (ss) { s += __shfl_xor(s, 16); s += __shfl_xor(s, 32); if (fq == 0) atomicAdd(ss + row, s); }
            }
    }
};

__device__ __forceinline__ float silu_f(float a) { return a * __builtin_amdgcn_rcpf(1.0f + __expf(-a)); }

struct EpiGU {
    static constexpr bool PERM = true, AFTER_DRAIN = false;
    bf16_t* HM; const float* ss1; const float* cw; const float* cb; const float* st;
    float* SG; float* SU; float* TG; float* ffp; float* ffs;
    __device__ __forceinline__ void operator()(const f32x4 (&acc)[2][2][4][2], const Unit& u, int wr, int wc, int fr, int fq) const {
        const int lane = fq * 16 + fr;
        const int col = u.pn * 128 + wc * 32 + 8 * fq;
        const int src1 = (lane & 48) | ((fr - 1) & 15), src2 = (lane & 48) | ((fr - 2) & 15);
        float w0[8], w1[8], w2[8], bb[8];
#pragma unroll
        for (int e = 0; e < 8; ++e) { w0[e] = cw[col + e]; w1[e] = cw[5632 + col + e]; w2[e] = cw[2 * 5632 + col + e]; bb[e] = cb[col + e]; }
        const bool samp = u.pm >= 32;
#pragma unroll
        for (int ai = 0; ai < 2; ++ai) {
            const int rb = u.pm * BM + ai * HALF + wr * 64, blk = rb >> 6;
            float r1p[8], r2p[8];
#pragma unroll
            for (int e = 0; e < 8; ++e) { r1p[e] = 0.f; r2p[e] = 0.f; }
#pragma unroll
            for (int m = 0; m < 4; ++m) {
                const int row = rb + 16 * m + fr;
                const float rs = rsqrtf(ss1[row] * (1.0f / 2048.0f) + 1e-6f);
                float g[8], up[8], r1[8], r2[8], p1[8], p2[8];
#pragma unroll
                for (int n = 0; n < 2; ++n)
#pragma unroll
                    for (int j = 0; j < 4; ++j) { g[4 * n + j] = acc[ai][0][m][n][j] * rs; up[4 * n + j] = acc[ai][1][m][n][j] * rs; }
#pragma unroll
                for (int e = 0; e < 8; ++e) { r1[e] = __shfl(g[e], src1); r2[e] = __shfl(g[e], src2); }
                bool do_store = true;
                if (!samp) {
#pragma unroll
                    for (int e = 0; e < 8; ++e) { p1[e] = fr >= 1 ? r1[e] : r1p[e]; p2[e] = fr >= 2 ? r2[e] : r2p[e]; }
                    if (m == 0 && fr < 2) {
                        float* sg = SG + (size_t)(blk * 2 + fr) * 5632 + col; float* su = SU + (size_t)(blk * 2 + fr) * 5632 + col;
                        *(f32x4*)sg = (f32x4){g[0], g[1], g[2], g[3]}; *(f32x4*)(sg + 4) = (f32x4){g[4], g[5], g[6], g[7]};
                        *(f32x4*)su = (f32x4){up[0], up[1], up[2], up[3]}; *(f32x4*)(su + 4) = (f32x4){up[4], up[5], up[6], up[7]};
                        do_store = false;
                    }
                    if (m == 3 && fr >= 14) {
                        float* tg = TG + (size_t)(blk * 2 + fr - 14) * 5632 + col;
                        *(f32x4*)tg = (f32x4){g[0], g[1], g[2], g[3]}; *(f32x4*)(tg + 4) = (f32x4){g[4], g[5], g[6], g[7]};
                        if ((blk & 31) == 31) { float* fo = ffp + (size_t)((blk >> 5) * 2 + fr - 14) * 5632 + col;
                            *(f32x4*)fo = (f32x4){g[0], g[1], g[2], g[3]}; *(f32x4*)(fo + 4) = (f32x4){g[4], g[5], g[6], g[7]}; }
                    }
                } else {
                    const int t = fr & 7, b = (row - 8192) >> 3;
                    float s0[8], s1[8];
#pragma unroll
                    for (int e = 0; e < 8; ++e) { s0[e] = 0.f; s1[e] = 0.f; }
                    if (t < 2) {
                        const float* sp = st + (size_t)(b * 2) * 5632 + col;
#pragma unroll
                        for (int e = 0; e < 8; ++e) { s0[e] = sp[e]; s1[e] = sp[5632 + e]; }
                    }
#pragma unroll
                    for (int e = 0; e < 8; ++e) { p1[e] = t >= 1 ? r1[e] : s1[e]; p2[e] = t >= 2 ? r2[e] : (t == 1 ? s1[e] : s0[e]); }
                    if (t >= 6) { float* fo = ffs + (size_t)(b * 2 + t - 6) * 5632 + col;
                        *(f32x4*)fo = (f32x4){g[0], g[1], g[2], g[3]}; *(f32x4*)(fo + 4) = (f32x4){g[4], g[5], g[6], g[7]}; }
                }
                if (do_store) {
                    float h[8];
#pragma unroll
                    for (int e = 0; e < 8; ++e) { const float a = w0[e] * p2[e] + w1[e] * p1[e] + w2[e] * g[e] + bb[e]; h[e] = silu_f(a) * up[e]; }
                    u32x4 w; w.x = cvt_pk_bf16(h[0], h[1]); w.y = cvt_pk_bf16(h[2], h[3]); w.z = cvt_pk_bf16(h[4], h[5]); w.w = cvt_pk_bf16(h[6], h[7]);
                    *(u32x4*)(HM + (size_t)row * 5632 + col) = w;
                }
#pragma unroll
                for (int e = 0; e < 8; ++e) { r1p[e] = r1[e]; r2p[e] = r2[e]; }
            }
        }
    }
};
}

#define LAS __attribute__((address_space(3)))
typedef unsigned short bf16;
typedef unsigned v4u __attribute__((ext_vector_type(4)));
typedef unsigned v2u __attribute__((ext_vector_type(2)));
typedef float f32x4 __attribute__((ext_vector_type(4)));
typedef short bf16x8 __attribute__((ext_vector_type(8)));

constexpr int DM = 2048, MP = 8192, MS = 1024, MT = 9216, SEQ = 2048, NIN = 4608, DFF = 5632;
constexpr int QK_OFF = 1024, QV_OFF = 1280, QB_OFF = 1536, QC_OFF = 2560, QU_OFF = 3584;
constexpr int NWAVES = 8, NTHR = 512;
constexpr int LDS_BYTES = 147456;
constexpr float EPS = 1e-6f;

constexpr size_t O_Y = 0, O_KWP = 18874368, O_VWP = 19005440, O_CVP = 19136512, O_FFP = 19144704,
                 O_KWS = 19189760, O_VWS = 23384064, O_CVS = 27578368, O_FFS = 27840512, O_END = 29282304;
constexpr size_t MiB = 1u << 20;
constexpr size_t WS_SS1 = 0;
constexpr size_t WS_BAR = 65536, CTL_ZERO_BYTES = 131072;
constexpr int LDS_XB_OFF = 131072 + 64;
constexpr size_t WS_WIN = 1 * MiB;
constexpr size_t WS_WOUT = 19 * MiB;
constexpr size_t WS_WGU = 27 * MiB;
constexpr size_t WS_WDN = 71 * MiB;
constexpr size_t WS_H = 93 * MiB;
constexpr size_t WS_MIX = 129 * MiB;
constexpr size_t WS_QKV = 165 * MiB;
constexpr size_t WS_ATT = 246 * MiB;
constexpr size_t WS_HM = 165 * MiB;
constexpr size_t WS_SG = 264 * MiB, WS_SU = 271 * MiB, WS_TG = 278 * MiB, WS_END = 285 * MiB;

struct Args { const float* in[20]; float* out; unsigned char* ws; int ph_lo, ph_hi; };

__device__ __forceinline__ unsigned f2bf(float f) { unsigned u = __builtin_bit_cast(unsigned, f); return (u + 0x7fffu + ((u >> 16) & 1u)) >> 16; }
__device__ __forceinline__ unsigned pk2(float lo, float hi) { return pg8::cvt_pk_bf16(lo, hi); }
__device__ __forceinline__ float bflo(unsigned w) { return __builtin_bit_cast(float, w << 16); }
__device__ __forceinline__ float bfhi(unsigned w) { return __builtin_bit_cast(float, w & 0xffff0000u); }
__device__ __forceinline__ float wave_sum(float v) {
#pragma unroll
    for (int o = 1; o < 64; o <<= 1) v += __shfl_xor(v, o);
    return v;
}
#define LDS_WAIT() asm volatile("s_waitcnt lgkmcnt(0)" ::: "memory")

template <int MODE>
__device__ __forceinline__ void p0_transpose_item(const float* W, int K, int N, bf16* WT, const float* kscale, LAS float* scr, int item, int lane) {
    const int nblk = N / 32, kb = item / nblk, nb = item % nblk, k0 = 64 * kb, n0 = 32 * nb;
    f32x4 v[8];
#pragma unroll
    for (int i = 0; i < 8; ++i) v[i] = *(const f32x4*)(W + (size_t)(k0 + 8 * i + (lane >> 3)) * N + n0 + 4 * (lane & 7));
#pragma unroll
    for (int i = 0; i < 8; ++i) { const int kk = 8 * i + (lane >> 3); f32x4 x = v[i]; if (kscale) x = x * kscale[k0 + kk];
        LAS float* d = scr + kk * 33 + 4 * (lane & 7); d[0] = x.x; d[1] = x.y; d[2] = x.z; d[3] = x.w; }
    LDS_WAIT(); asm volatile("" ::: "memory");
    const int c = lane & 7;
#pragma unroll
    for (int j = 0; j < 4; ++j) { const int n = (lane >> 3) + 8 * j; const LAS float* s = scr + (8 * c) * 33 + n;
        v4u o; o.x = pk2(s[0 * 33], s[1 * 33]); o.y = pk2(s[2 * 33], s[3 * 33]); o.z = pk2(s[4 * 33], s[5 * 33]); o.w = pk2(s[6 * 33], s[7 * 33]);
        const int nn = n0 + n; const int drow = MODE == 0 ? nn : ((nn >> 7) * 256 + (MODE - 1) * 128 + (nn & 127));
        *(v4u*)(WT + (size_t)drow * K + k0 + 8 * c) = o; }
    LDS_WAIT(); asm volatile("" ::: "memory");
}

__device__ __forceinline__ void rms_row_to_bf16(const float* xrow, const float* g, bf16* orow, int lane) {
    const f32x4* xr = (const f32x4*)xrow + lane; const f32x4* gr = (const f32x4*)g + lane;
    f32x4 v[8]; float s = 0.f;
#pragma unroll
    for (int j = 0; j < 8; ++j) { v[j] = xr[64 * j]; s += (v[j].x * v[j].x + v[j].y * v[j].y) + (v[j].z * v[j].z + v[j].w * v[j].w); }
    const float rs = rsqrtf(wave_sum(s) * (1.0f / 2048.0f) + EPS);
    v2u* o8 = (v2u*)orow + lane;
#pragma unroll
    for (int j = 0; j < 8; ++j) { const f32x4 gg = gr[64 * j]; v2u o; o.x = pk2(v[j].x * rs * gg.x, v[j].y * rs * gg.y); o.y = pk2(v[j].z * rs * gg.z, v[j].w * rs * gg.w); o8[64 * j] = o; }
}

constexpr int KS_PITCH = 144, VT_PITCH = 560, KS_BYTES = 272 * KS_PITCH, VT_OFF = KS_BYTES;

__device__ __forceinline__ void attn_job(const LAS unsigned char* Ks, const LAS unsigned char* Vt, const bf16* qptr, float slope, float sink,
                                         int qpos, int jt0, int keymin, bf16* optr, int lane) {
    const int c = lane & 15, g = lane >> 4;
    bf16x8 qf[2];
#pragma unroll
    for (int ks = 0; ks < 2; ++ks) qf[ks] = *(const bf16x8*)(qptr + 32 * ks + 8 * g);
    f32x4 o[4];
#pragma unroll
    for (int dt = 0; dt < 4; ++dt) o[dt] = (f32x4){0.f, 0.f, 0.f, 0.f};
    float mx = sink, sum = 0.f;
#pragma unroll 1
    for (int s = 0; s < 5; ++s) {
        const int jt = jt0 + 2 * s;
        f32x4 st[2];
#pragma unroll
        for (int t = 0; t < 2; ++t) {
            f32x4 a = (f32x4){0.f, 0.f, 0.f, 0.f};
#pragma unroll
            for (int ks = 0; ks < 2; ++ks) {
                const bf16x8 kf = *(const LAS bf16x8*)(Ks + (16 * (jt + t) + c) * KS_PITCH + (32 * ks + 8 * g) * 2);
                a = __builtin_amdgcn_mfma_f32_16x16x32_bf16(kf, qf[ks], a, 0, 0, 0);
            }
            st[t] = a;
        }
        float lm = -1e30f;
#pragma unroll
        for (int t = 0; t < 2; ++t)
#pragma unroll
            for (int i = 0; i < 4; ++i) {
                const int key = 16 * (jt + t) + 4 * g + i, dist = qpos - key;
                const bool valid = dist >= 0 && dist <= 128 && key >= keymin;
                const float sc = valid ? st[t][i] * 0.125f - slope * (float)dist : -1e30f;
                st[t][i] = sc; lm = fmaxf(lm, sc);
            }
        lm = fmaxf(lm, __shfl_xor(lm, 16)); lm = fmaxf(lm, __shfl_xor(lm, 32));
        const float mn = fmaxf(mx, lm), alpha = __expf(mx - mn);
        mx = mn; sum *= alpha;
#pragma unroll
        for (int dt = 0; dt < 4; ++dt) o[dt] = o[dt] * alpha;
#pragma unroll
        for (int t = 0; t < 2; ++t)
#pragma unroll
            for (int i = 0; i < 4; ++i) { const float p = __expf(st[t][i] - mn); st[t][i] = p; sum += p; }
        v4u pw; pw.x = pk2(st[0][0], st[0][1]); pw.y = pk2(st[0][2], st[0][3]); pw.z = pk2(st[1][0], st[1][1]); pw.w = pk2(st[1][2], st[1][3]);
        const bf16x8 pb = __builtin_bit_cast(bf16x8, pw);
#pragma unroll
        for (int dt = 0; dt < 4; ++dt) {
            const LAS unsigned char* vp = Vt + (16 * dt + c) * VT_PITCH + (16 * jt + 4 * g) * 2;
            const v2u lo = *(const LAS v2u*)vp, hi = *(const LAS v2u*)(vp + 32);
            v4u vw; vw.x = lo.x; vw.y = lo.y; vw.z = hi.x; vw.w = hi.y;
            o[dt] = __builtin_amdgcn_mfma_f32_16x16x32_bf16(__builtin_bit_cast(bf16x8, vw), pb, o[dt], 0, 0, 0);
        }
    }
    sum += __shfl_xor(sum, 16); sum += __shfl_xor(sum, 32); sum += __expf(sink - mx);
    const float inv = 1.0f / sum;
#pragma unroll
    for (int dt = 0; dt < 4; ++dt) { v2u w; w.x = pk2(o[dt][0] * inv, o[dt][1] * inv); w.y = pk2(o[dt][2] * inv, o[dt][3] * inv); *(v2u*)(optr + 16 * dt + 4 * g) = w; }
}

__device__ __forceinline__ void attn_phase(const Args& a, LAS unsigned char* lds, int tid, int lane, int wave) {
    const bf16* QKV = (const bf16*)(a.ws + WS_QKV); bf16* ATT = (bf16*)(a.ws + WS_ATT);
    const float* cache_k = a.in[2]; const float* cache_v = a.in[3]; const float* sinks = a.in[8];
    float* out = a.out;
    LAS unsigned char* Ks = lds; LAS unsigned char* Vt = lds + VT_OFF;
    const int c = lane & 15;
    for (int unit = blockIdx.x; unit < 768; unit += gridDim.x) {
        __syncthreads();
        if (unit < 256) {
            const int b = unit >> 6, nb = (unit >> 2) & 15, kvh = unit & 3;
#pragma unroll 1
            for (int ch = tid; ch < 272 * 8; ch += NTHR) {
                const int j = ch >> 3, part = ch & 7, tok = (nb - 1) * 128 + j;
                v4u kk = (v4u){0u, 0u, 0u, 0u}, vv = (v4u){0u, 0u, 0u, 0u};
                if (j < 256 && tok >= 0) {
                    const bf16* src = QKV + (size_t)(b * SEQ + tok) * NIN + QK_OFF + kvh * 64 + part * 8;
                    kk = *(const v4u*)src; vv = *(const v4u*)(src + 256);
                    if (nb == 15 && j >= 128) {
                        float* ko = out + O_KWP + ((size_t)(b * 128 + j - 128) * 4 + kvh) * 64 + part * 8; float* vo = out + O_VWP + ((size_t)(b * 128 + j - 128) * 4 + kvh) * 64 + part * 8;
                        *(f32x4*)ko = (f32x4){bflo(kk.x), bfhi(kk.x), bflo(kk.y), bfhi(kk.y)}; *(f32x4*)(ko + 4) = (f32x4){bflo(kk.z), bfhi(kk.z), bflo(kk.w), bfhi(kk.w)};
                        *(f32x4*)vo = (f32x4){bflo(vv.x), bfhi(vv.x), bflo(vv.y), bfhi(vv.y)}; *(f32x4*)(vo + 4) = (f32x4){bflo(vv.z), bfhi(vv.z), bflo(vv.w), bfhi(vv.w)};
                    }
                }
                *(LAS v4u*)(Ks + j * KS_PITCH + part * 16) = kk;
                LAS unsigned short* vt = (LAS unsigned short*)(Vt + (part * 8) * VT_PITCH + j * 2);
                vt[0 * (VT_PITCH / 2)] = (unsigned short)(vv.x & 0xffffu); vt[1 * (VT_PITCH / 2)] = (unsigned short)(vv.x >> 16);
                vt[2 * (VT_PITCH / 2)] = (unsigned short)(vv.y & 0xffffu); vt[3 * (VT_PITCH / 2)] = (unsigned short)(vv.y >> 16);
                vt[4 * (VT_PITCH / 2)] = (unsigned short)(vv.z & 0xffffu); vt[5 * (VT_PITCH / 2)] = (unsigned short)(vv.z >> 16);
                vt[6 * (VT_PITCH / 2)] = (unsigned short)(vv.w & 0xffffu); vt[7 * (VT_PITCH / 2)] = (unsigned short)(vv.w >> 16);
            }
            __syncthreads();
            const int rt = wave;
            const size_t qrow = (size_t)(b * SEQ + nb * 128 + 16 * rt + c);
#pragma unroll 1
            for (int hq = 0; hq < 4; ++hq) {
                const int h = kvh * 4 + hq;
                const float slope = exp2f(-0.5f * (float)(h + 1)), sink = sinks[h];
                attn_job(Ks, Vt, QKV + qrow * NIN + h * 64, slope, sink, 16 * rt + c + 128, rt, nb > 0 ? 0 : 128, ATT + qrow * 1024 + h * 64, lane);
            }
        } else {
            const int su = unit - 256, b = su >> 2, kvh = su & 3;
#pragma unroll 1
            for (int ch = tid; ch < 160 * 8; ch += NTHR) {
                const int j = ch >> 3, part = ch & 7;
                v4u kk = (v4u){0u, 0u, 0u, 0u}, vv = (v4u){0u, 0u, 0u, 0u};
                if (j < 128) {
                    const size_t off = ((size_t)(b * 128 + j) * 4 + kvh) * 64 + part * 8;
                    const f32x4 k0 = *(const f32x4*)(cache_k + off), k1 = *(const f32x4*)(cache_k + off + 4), v0 = *(const f32x4*)(cache_v + off), v1 = *(const f32x4*)(cache_v + off + 4);
                    kk.x = pk2(k0.x, k0.y); kk.y = pk2(k0.z, k0.w); kk.z = pk2(k1.x, k1.y); kk.w = pk2(k1.z, k1.w);
                    vv.x = pk2(v0.x, v0.y); vv.y = pk2(v0.z, v0.w); vv.z = pk2(v1.x, v1.y); vv.w = pk2(v1.z, v1.w);
                    if (j >= 8) { const size_t oo = ((size_t)(b * 128 + j - 8) * 4 + kvh) * 64 + part * 8;
                        *(f32x4*)(out + O_KWS + oo) = k0; *(f32x4*)(out + O_KWS + oo + 4) = k1; *(f32x4*)(out + O_VWS + oo) = v0; *(f32x4*)(out + O_VWS + oo + 4) = v1; }
                } else if (j < 136) {
                    const bf16* src = QKV + (size_t)(MP + b * 8 + j - 128) * NIN + QK_OFF + kvh * 64 + part * 8;
                    kk = *(const v4u*)src; vv = *(const v4u*)(src + 256);
                    const size_t oo = ((size_t)(b * 128 + j - 8) * 4 + kvh) * 64 + part * 8;
                    float* ko = out + O_KWS + oo; float* vo = out + O_VWS + oo;
                    *(f32x4*)ko = (f32x4){bflo(kk.x), bfhi(kk.x), bflo(kk.y), bfhi(kk.y)}; *(f32x4*)(ko + 4) = (f32x4){bflo(kk.z), bfhi(kk.z), bflo(kk.w), bfhi(kk.w)};
                    *(f32x4*)vo = (f32x4){bflo(vv.x), bfhi(vv.x), bflo(vv.y), bfhi(vv.y)}; *(f32x4*)(vo + 4) = (f32x4){bflo(vv.z), bfhi(vv.z), bflo(vv.w), bfhi(vv.w)};
                }
                *(LAS v4u*)(Ks + j * KS_PITCH + part * 16) = kk;
                LAS unsigned short* vt = (LAS unsigned short*)(Vt + (part * 8) * VT_PITCH + j * 2);
                vt[0 * (VT_PITCH / 2)] = (unsigned short)(vv.x & 0xffffu); vt[1 * (VT_PITCH / 2)] = (unsigned short)(vv.x >> 16);
                vt[2 * (VT_PITCH / 2)] = (unsigned short)(vv.y & 0xffffu); vt[3 * (VT_PITCH / 2)] = (unsigned short)(vv.y >> 16);
                vt[4 * (VT_PITCH / 2)] = (unsigned short)(vv.z & 0xffffu); vt[5 * (VT_PITCH / 2)] = (unsigned short)(vv.z >> 16);
                vt[6 * (VT_PITCH / 2)] = (unsigned short)(vv.w & 0xffffu); vt[7 * (VT_PITCH / 2)] = (unsigned short)(vv.w >> 16);
            }
            __syncthreads();
            if (wave < 2) {
                const int qi = c & 7, h = kvh * 4 + 2 * wave + (c >> 3);
                const float slope = exp2f(-0.5f * (float)(h + 1)), sink = sinks[h];
                const size_t qrow = (size_t)(MP + b * 8 + qi);
                attn_job(Ks, Vt, QKV + qrow * NIN + h * 64, slope, sink, qi + 128, 0, 0, ATT + qrow * 1024 + h * 64, lane);
            }
        }
    }
}

__device__ __forceinline__ void load16bf(const bf16* p, float (&f)[16]) {
    const v4u a = *(const v4u*)p, b = *(const v4u*)(p + 8);
    f[0] = bflo(a.x); f[1] = bfhi(a.x); f[2] = bflo(a.y); f[3] = bfhi(a.y); f[4] = bflo(a.z); f[5] = bfhi(a.z); f[6] = bflo(a.w); f[7] = bfhi(a.w);
    f[8] = bflo(b.x); f[9] = bfhi(b.x); f[10] = bflo(b.y); f[11] = bfhi(b.y); f[12] = bflo(b.z); f[13] = bfhi(b.z); f[14] = bflo(b.w); f[15] = bfhi(b.w);
}
__device__ __forceinline__ void store16bf(bf16* p, const float (&f)[16]) {
    v4u a, b; a.x = pk2(f[0], f[1]); a.y = pk2(f[2], f[3]); a.z = pk2(f[4], f[5]); a.w = pk2(f[6], f[7]); b.x = pk2(f[8], f[9]); b.y = pk2(f[10], f[11]); b.z = pk2(f[12], f[13]); b.w = pk2(f[14], f[15]);
    *(v4u*)p = a; *(v4u*)(p + 8) = b;
}
__device__ __forceinline__ void load16f(const float* p, float (&f)[16]) {
#pragma unroll
    for (int q = 0; q < 4; ++q) { const f32x4 v = *(const f32x4*)(p + 4 * q); f[4 * q] = v.x; f[4 * q + 1] = v.y; f[4 * q + 2] = v.z; f[4 * q + 3] = v.w; }
}
__device__ __forceinline__ void store16f(float* p, const float (&f)[16]) {
#pragma unroll
    for (int q = 0; q < 4; ++q) *(f32x4*)(p + 4 * q) = (f32x4){f[4 * q], f[4 * q + 1], f[4 * q + 2], f[4 * q + 3]};
}
__device__ __forceinline__ void mix_row(const Args& a, int r, int lane) {
    const bf16* QKV = (const bf16*)(a.ws + WS_QKV); const bf16* ATT = (const bf16*)(a.ws + WS_ATT); bf16* MIX = (bf16*)(a.ws + WS_MIX);
    const float* state_conv = a.in[4]; const float* conv_w = a.in[9]; const float* gA = a.in[10]; const float* gB = a.in[11];
    const int c0 = lane * 16;
    float x[16], gg[16];
    load16bf(ATT + (size_t)r * 1024 + c0, x);
    float s = 0.f;
#pragma unroll
    for (int e = 0; e < 16; ++e) s += x[e] * x[e];
    float rs = rsqrtf(wave_sum(s) * (1.0f / 1024.0f) + EPS);
    load16f(gA + c0, gg);
#pragma unroll
    for (int e = 0; e < 16; ++e) x[e] = x[e] * rs * gg[e];
    store16bf(MIX + (size_t)r * 2048 + c0, x);
    float Bv[16], Cv[16], Uv[16], cu[16], p1[16], p2[16], w0[16], w1[16], w2[16];
    const bf16* qr = QKV + (size_t)r * NIN;
    load16bf(qr + QB_OFF + c0, Bv); load16bf(qr + QC_OFF + c0, Cv); load16bf(qr + QU_OFF + c0, Uv);
#pragma unroll
    for (int e = 0; e < 16; ++e) { cu[e] = Cv[e] * Uv[e]; p1[e] = 0.f; p2[e] = 0.f; }
    int t, nseq; float* cs_out;
    if (r < MP) { t = r & (SEQ - 1); nseq = SEQ; cs_out = a.out + O_CVP + (size_t)((r >> 11) * 2) * 1024 + c0; }
    else { t = (r - MP) & 7; nseq = 8; cs_out = a.out + O_CVS + (size_t)(((r - MP) >> 3) * 2) * 1024 + c0; }
    if (t >= 1) { load16bf(qr - NIN + QC_OFF + c0, Cv); load16bf(qr - NIN + QU_OFF + c0, Uv);
#pragma unroll
        for (int e = 0; e < 16; ++e) p1[e] = Cv[e] * Uv[e]; }
    else if (r >= MP) load16f(state_conv + (size_t)(((r - MP) >> 3) * 2 + 1) * 1024 + c0, p1);
    if (t >= 2) { load16bf(qr - 2 * NIN + QC_OFF + c0, Cv); load16bf(qr - 2 * NIN + QU_OFF + c0, Uv);
#pragma unroll
        for (int e = 0; e < 16; ++e) p2[e] = Cv[e] * Uv[e]; }
    else if (r >= MP) load16f(state_conv + (size_t)(((r - MP) >> 3) * 2 + t) * 1024 + c0, p2);
    if (t >= nseq - 2) store16f(cs_out + (size_t)(t - (nseq - 2)) * 1024, cu);
    load16f(conv_w + c0, w0); load16f(conv_w + 1024 + c0, w1); load16f(conv_w + 2048 + c0, w2);
    s = 0.f;
#pragma unroll
    for (int e = 0; e < 16; ++e) { x[e] = Bv[e] * (w0[e] * p2[e] + w1[e] * p1[e] + w2[e] * cu[e]); s += x[e] * x[e]; }
    rs = rsqrtf(wave_sum(s) * (1.0f / 1024.0f) + EPS);
    load16f(gB + c0, gg);
#pragma unroll
    for (int e = 0; e < 16; ++e) x[e] = x[e] * rs * gg[e];
    store16bf(MIX + (size_t)r * 2048 + 1024 + c0, x);
}

__device__ __forceinline__ void fixup_phase(const Args& a, int gtid, int gthreads) {
    const float* SG = (const float*)(a.ws + WS_SG); const float* SU = (const float*)(a.ws + WS_SU); const float* TG = (const float*)(a.ws + WS_TG);
    const float* cw = a.in[16]; const float* cb = a.in[17]; bf16* HM = (bf16*)(a.ws + WS_HM);
    constexpr int C4 = DFF / 4;
    for (int it = gtid; it < 128 * 2 * C4; it += gthreads) {
        const int c = (it % C4) * 4, bi = it / C4, i = bi & 1, blk = bi >> 1;
        const bool start = (blk & 31) == 0;
        const f32x4 z = (f32x4){0.f, 0.f, 0.f, 0.f};
        const f32x4 g0 = *(const f32x4*)(SG + (size_t)(blk * 2 + i) * DFF + c), u0 = *(const f32x4*)(SU + (size_t)(blk * 2 + i) * DFF + c);
        f32x4 p1, p2;
        if (i == 0) { p1 = start ? z : *(const f32x4*)(TG + (size_t)((blk - 1) * 2 + 1) * DFF + c); p2 = start ? z : *(const f32x4*)(TG + (size_t)((blk - 1) * 2) * DFF + c); }
        else { p1 = *(const f32x4*)(SG + (size_t)(blk * 2) * DFF + c); p2 = start ? z : *(const f32x4*)(TG + (size_t)((blk - 1) * 2 + 1) * DFF + c); }
        const f32x4 w0 = *(const f32x4*)(cw + c), w1 = *(const f32x4*)(cw + DFF + c), w2 = *(const f32x4*)(cw + 2 * DFF + c), bb = *(const f32x4*)(cb + c);
        float h[4];
#pragma unroll
        for (int e = 0; e < 4; ++e) { const float av = w0[e] * p2[e] + w1[e] * p1[e] + w2[e] * g0[e] + bb[e]; h[e] = pg8::silu_f(av) * u0[e]; }
        v2u w; w.x = pk2(h[0], h[1]); w.y = pk2(h[2], h[3]);
        *(v2u*)(HM + (size_t)(blk * 64 + i) * DFF + c) = w;
    }
}

__device__ __forceinline__ void final_row(float* row, const float* g, int lane) {
    f32x4* xr = (f32x4*)row + lane; const f32x4* gr = (const f32x4*)g + lane;
    f32x4 v[8]; float s = 0.f;
#pragma unroll
    for (int j = 0; j < 8; ++j) { v[j] = xr[64 * j]; s += (v[j].x * v[j].x + v[j].y * v[j].y) + (v[j].z * v[j].z + v[j].w * v[j].w); }
    const float rs = rsqrtf(wave_sum(s) * (1.0f / 2048.0f) + EPS);
#pragma unroll
    for (int j = 0; j < 8; ++j) { const f32x4 gg = gr[64 * j]; xr[64 * j] = (f32x4){v[j].x * rs * gg.x, v[j].y * rs * gg.y, v[j].z * rs * gg.z, v[j].w * rs * gg.w}; }
}

#define XB_TMO      128
#define XB_XCNT(j)  (256  + 64 * (j))
#define XB_XSUB(j)  (1280 + 64 * (j))
#define XB_XGEN(j)  (2304 + 64 * (j))
#define XB_TOP      3328
#define XB_TOPGEN   3392
#define XCD_BAR_WORDS 3456
#define XB_SPIN_CAP (1u << 18)

__device__ __forceinline__ unsigned xb_ld(unsigned* p)              { return __hip_atomic_load(p, __ATOMIC_RELAXED, __HIP_MEMORY_SCOPE_AGENT); }
__device__ __forceinline__ unsigned xb_add(unsigned* p, unsigned v) { return __hip_atomic_fetch_add(p, v, __ATOMIC_RELAXED, __HIP_MEMORY_SCOPE_AGENT); }
__device__ __forceinline__ unsigned xb_xcc_id() { return (unsigned)__builtin_amdgcn_s_getreg((3 << 11) | 20) & 0xFu; }
#define XB_SPIN(cond, bar) do { unsigned _sp = 0; while (cond) { __builtin_amdgcn_s_sleep(1); \
    if ((++_sp & 255u) == 0u) { if (xb_ld(&(bar)[XB_TMO])) break; if (_sp > XB_SPIN_CAP) { atomicAdd(&(bar)[XB_TMO], 1u); break; } } } } while (0)

struct XcdBarrier {
    unsigned* bar; unsigned x;
    volatile LAS unsigned* st;
};

__device__ __forceinline__ XcdBarrier xcd_barrier_post(unsigned* bar, volatile LAS unsigned* st) {
    XcdBarrier b; b.bar = bar; b.x = xb_xcc_id(); b.st = st;
    if (threadIdx.x == 0) (void)xb_add(&bar[XB_XCNT(b.x)], 1u);
    return b;
}
__device__ __forceinline__ void xcd_barrier_complete(unsigned* bar, unsigned x, unsigned& nloc, unsigned& nx) {
    const unsigned G = gridDim.x * gridDim.y * gridDim.z;
    unsigned sum, cnt, mine, sp = 0u;
    for (;;) {
        sum = 0u; cnt = 0u; mine = 0u;
#pragma unroll
        for (unsigned j = 0; j < 16; ++j) { const unsigned c = xb_ld(&bar[XB_XCNT(j)]); sum += c; cnt += (c > 0u) ? 1u : 0u; mine = (j == x) ? c : mine; }
        if (sum == G) break;
        __builtin_amdgcn_s_sleep(1);
        if ((++sp & 255u) == 0u) { if (xb_ld(&bar[XB_TMO])) break; if (sp > XB_SPIN_CAP) { atomicAdd(&bar[XB_TMO], 1u); break; } }
    }
    nloc = mine > 0u ? mine : 1u; nx = cnt > 0u ? cnt : 1u;
}

__device__ __forceinline__ void xcd_barrier(const XcdBarrier& b) {
    asm volatile("s_waitcnt vmcnt(0)" ::: "memory");
    __syncthreads();
    if (threadIdx.x == 0) {
        unsigned* bar = b.bar;
        __builtin_amdgcn_s_waitcnt(0);
        unsigned nloc = b.st[0], nx = b.st[1];
        if (nloc == 0u) { xcd_barrier_complete(bar, b.x, nloc, nx); b.st[0] = nloc; b.st[1] = nx; }
        const unsigned old = xb_add(&bar[XB_XSUB(b.x)], 1u);
        const unsigned gen = old / nloc;
        if (old + 1u == (gen + 1u) * nloc) {
            __builtin_amdgcn_fence(__ATOMIC_RELEASE, "agent");
            asm volatile("s_waitcnt vmcnt(0)" ::: "memory");
            const unsigned og = xb_add(&bar[XB_TOP], 1u);
            const unsigned tg = og / nx;
            if (og + 1u == (tg + 1u) * nx) xb_add(&bar[XB_TOPGEN], 1u);
            else XB_SPIN(xb_ld(&bar[XB_TOPGEN]) == tg, bar);
            __builtin_amdgcn_fence(__ATOMIC_ACQUIRE, "agent");
            xb_add(&bar[XB_XGEN(b.x)], 1u);
            asm volatile("s_waitcnt vmcnt(0)" ::: "memory");
        } else {
            XB_SPIN(xb_ld(&bar[XB_XGEN(b.x)]) == gen, bar);
            __builtin_amdgcn_fence(__ATOMIC_ACQUIRE, "agent");
            asm volatile("s_waitcnt vmcnt(0)" ::: "memory");
        }
    }
    __syncthreads();
}


#ifndef ONE_LAUNCH
#define ONE_LAUNCH 1
#endif
constexpr int NPHASE = 9;


__global__ void __launch_bounds__(NTHR, 2) hymba_fwd(Args a) {
    extern __shared__ __attribute__((aligned(16))) unsigned char lds_raw[];
    LAS unsigned char* lds = (LAS unsigned char*)lds_raw;
    cg::grid_group grid = cg::this_grid();
    const int tid = threadIdx.x, lane = tid & 63, wave = __builtin_amdgcn_readfirstlane(tid >> 6);
    const int G = gridDim.x, bx = blockIdx.x;
    const int vcu = (G % 8 == 0) ? (bx % 8) * (G / 8) + bx / 8 : bx;
    const int gw = vcu * NWAVES + wave, NGW = G * NWAVES;
    const int lo = a.ph_lo, hi = a.ph_hi;
    unsigned char* ws = a.ws;
#ifndef PHMASK
#define PHMASK 0x1ff
#endif
#define IN(k) (((PHMASK >> (k)) & 1) && lo <= (k) && (k) < hi)
#define SEAM(k) do { if (IN(k) && IN((k) + 1)) xcd_barrier(xbar); } while (0)
    if (tid < 4) ((LAS unsigned*)(lds + LDS_XB_OFF))[tid] = 0u;
    __syncthreads();
    XcdBarrier xbar = xcd_barrier_post((unsigned*)(ws + WS_BAR), (volatile LAS unsigned*)(lds + LDS_XB_OFF));
    if (hi > 1000) grid.sync();

    if (IN(0)) {
        LAS float* scr = (LAS float*)(lds + wave * 16384);
        constexpr int I_IN = (DM / 64) * (NIN / 32), I_OUT = (DM / 64) * (DM / 32), I_G = (DM / 64) * (DFF / 32), I_DN = (DFF / 64) * (DM / 32);
        constexpr int NITEMS = I_IN + I_OUT + 2 * I_G + I_DN;
        for (int it = gw; it < NITEMS; it += NGW) {
            int r = it;
            if (r < I_IN) { p0_transpose_item<0>(a.in[7], DM, NIN, (bf16*)(ws + WS_WIN), nullptr, scr, r, lane); continue; } r -= I_IN;
            if (r < I_OUT) { p0_transpose_item<0>(a.in[12], DM, DM, (bf16*)(ws + WS_WOUT), nullptr, scr, r, lane); continue; } r -= I_OUT;
            if (r < I_G) { p0_transpose_item<1>(a.in[14], DM, DFF, (bf16*)(ws + WS_WGU), a.in[13], scr, r, lane); continue; } r -= I_G;
            if (r < I_G) { p0_transpose_item<2>(a.in[15], DM, DFF, (bf16*)(ws + WS_WGU), a.in[13], scr, r, lane); continue; } r -= I_G;
            p0_transpose_item<0>(a.in[18], DFF, DM, (bf16*)(ws + WS_WDN), nullptr, scr, r, lane);
        }
        for (int m = gw; m < MT; m += NGW) {
            const float* xrow = m < MP ? a.in[0] + (size_t)m * DM : a.in[1] + (size_t)(m - MP) * DM;
            rms_row_to_bf16(xrow, a.in[6], (bf16*)(ws + WS_H) + (size_t)m * DM, lane);
        }
        for (int i = bx * NTHR + tid; i < MT; i += G * NTHR) ((float*)(ws + WS_SS1))[i] = 0.f;
    }
    SEAM(0);
    if (IN(1)) {
        __syncthreads();
        pg8::Gemm g{(const pg8::bf16_t*)(ws + WS_H), (const pg8::bf16_t*)(ws + WS_WIN), MT, NIN, DM}; pg8::StaticOrder S; S.init(MT, NIN, G, bx);
        pg8::EpiBf16<0> E{(pg8::bf16_t*)(ws + WS_QKV), NIN, nullptr, 0, 0, 1.f};
        pg8::gemm_phase<pg8::EpiBf16<0>, pg8::StaticOrder, true, true>(lds, g, S, E);
    }
    SEAM(1);
    if (IN(2)) { __syncthreads(); attn_phase(a, lds, tid, lane, wave); }
    SEAM(2);
    if (IN(3)) { for (int m = gw; m < MT; m += NGW) mix_row(a, m, lane); }
    SEAM(3);
    if (IN(4)) {
        __syncthreads();
        pg8::Gemm g{(const pg8::bf16_t*)(ws + WS_MIX), (const pg8::bf16_t*)(ws + WS_WOUT), MT, DM, DM}; pg8::StaticOrder S; S.init(MT, DM, G, bx);
        pg8::EpiRes E{a.in[0], a.in[1], a.out + O_Y, (pg8::bf16_t*)(ws + WS_H), (float*)(ws + WS_SS1)};
        pg8::gemm_phase<pg8::EpiRes, pg8::StaticOrder, true, true>(lds, g, S, E);
    }
    SEAM(4);
    if (IN(5)) {
        __syncthreads();
        pg8::Gemm g{(const pg8::bf16_t*)(ws + WS_H), (const pg8::bf16_t*)(ws + WS_WGU), MT, 2 * DFF, DM}; pg8::StaticOrder S; S.init(MT, 2 * DFF, G, bx);
        pg8::EpiGU E{(pg8::bf16_t*)(ws + WS_HM), (const float*)(ws + WS_SS1), a.in[16], a.in[17], a.in[5],
                     (float*)(ws + WS_SG), (float*)(ws + WS_SU), (float*)(ws + WS_TG), a.out + O_FFP, a.out + O_FFS};
        pg8::gemm_phase<pg8::EpiGU, pg8::StaticOrder, true, true>(lds, g, S, E);
    }
    SEAM(5);
    if (IN(6)) fixup_phase(a, bx * NTHR + tid, G * NTHR);
    SEAM(6);
    if (IN(7)) {
        __syncthreads();
        pg8::Gemm g{(const pg8::bf16_t*)(ws + WS_HM), (const pg8::bf16_t*)(ws + WS_WDN), MT, DM, DFF}; pg8::StaticOrder S; S.init(MT, DM, G, bx);
        pg8::EpiRes E{a.out + O_Y, a.out + O_Y + (size_t)MP * DM, a.out + O_Y, nullptr, nullptr};
        pg8::gemm_phase<pg8::EpiRes, pg8::StaticOrder, true, true>(lds, g, S, E);
    }
    SEAM(7);
    if (IN(8)) { for (int m = gw; m < MT; m += NGW) final_row(a.out + O_Y + (size_t)m * DM, a.in[19], lane); }
#undef IN
#undef SEAM
}

extern "C" void kernel_launch(void* const* d_in, const int* in_sizes, int n_in, void* d_out, int out_size, void* d_ws, size_t ws_size, hipStream_t stream) {
    static int grid = 0;
    if (grid == 0) {
        if (n_in != 20 || out_size != (int)O_END || ws_size < WS_END) { fprintf(stderr, "kernel_launch: unexpected shapes (n_in %d, out %d, ws %zu)\n", n_in, out_size, ws_size); grid = -1; return; }
        int dev = 0, cus = 0, per_cu = 0;
        (void)hipGetDevice(&dev); (void)hipDeviceGetAttribute(&cus, hipDeviceAttributeMultiprocessorCount, dev);
        if (hipFuncSetAttribute((const void*)hymba_fwd, hipFuncAttributeMaxDynamicSharedMemorySize, LDS_BYTES) != hipSuccess) { fprintf(stderr, "kernel_launch: hipFuncSetAttribute failed\n"); grid = -1; return; }
        if (hipOccupancyMaxActiveBlocksPerMultiprocessor(&per_cu, (const void*)hymba_fwd, NTHR, LDS_BYTES) != hipSuccess || per_cu < 1) { fprintf(stderr, "kernel_launch: occupancy query says %d\n", per_cu); per_cu = 1; }
        (void)hipGetLastError();
        grid = cus * per_cu;
        fprintf(stderr, "kernel_launch: grid %d (cus %d x %d)\n", grid, cus, per_cu);
    }
    if (grid < 0) return;
    (void)hipMemsetAsync(d_ws, 0, CTL_ZERO_BYTES, stream);
    Args a{};
    for (int i = 0; i < 20; ++i) a.in[i] = (const float*)d_in[i];
    a.out = (float*)d_out; a.ws = (unsigned char*)d_ws;
#if ONE_LAUNCH
    a.ph_lo = 0; a.ph_hi = NPHASE;
    void* args[] = {&a};
    hipError_t e = hipLaunchCooperativeKernel((const void*)hymba_fwd, dim3(grid), dim3(NTHR), args, LDS_BYTES, stream);
    if (e != hipSuccess) fprintf(stderr, "kernel_launch: cooperative launch failed: %s (grid %d)\n", hipGetErrorString(e), grid);
#else
    for (int p = 0; p < NPHASE; ++p) {
        a.ph_lo = p; a.ph_hi = p + 1;
        hipLaunchKernelGGL(hymba_fwd, dim3(grid), dim3(NTHR), LDS_BYTES, stream, a);
    }
#endif
}
```

```cpp
#include <hip/hip_runtime.h>
#include <hip/hip_cooperative_groups.h>
#include <cstdio>
#include <cstdint>
namespace cg = cooperative_groups;
namespace pg8 {
#define PG8_LAS __attribute__((address_space(3)))
typedef unsigned short bf16_t;
typedef short bf16x8 __attribute__((ext_vector_type(8)));
typedef float f32x4 __attribute__((ext_vector_type(4)));
typedef unsigned u32x4 __attribute__((ext_vector_type(4)));
constexpr int BM = 256, BK = 64, HALF = 128, HTB = HALF * BK * 2  , STAGE_BYTES = 8 * HTB, NXCD = 8, WGM = 8;

__host__ __device__ __forceinline__ int lds_byte(int r, int c) { const int st = (r >> 4) * 2 + (c >> 5), rr = r & 15, cc = c & 31, ob = rr * 64 + cc * 2; return st * 1024 + (ob ^ (((ob >> 9) & 1) << 5)); }
__host__ __device__ __forceinline__ void stage_rc(int b, int& R, int& C) { const int st = b / 1024, sb = b % 1024, swz = sb ^ (((sb >> 9) & 1) << 5); R = (st >> 1) * 16 + swz / 64; C = (st & 1) * 32 + (swz % 64) / 2; }
__host__ __device__ __forceinline__ int perm32(int rho) { const int n = rho >> 4, i = rho & 15; return 8 * (i >> 2) + 4 * n + (i & 3); }

struct Unit { int pm, pn, kt0, nkt, split; };
struct Gemm { const bf16_t* A; const bf16_t* Bt; int M, N, K; };

struct StaticOrder {
    int nM, nN, nwg, G, c;
    __host__ __device__ void init(int M, int N, int G_, int c_) { nM = M / BM; nN = N / BM; nwg = nM * nN; G = G_; c = c_; }
    __host__ __device__ bool next(int i, Unit& u) const {
        const long L = (long)i * G + c; if (L >= nwg) return false;
        int wgid = (int)L; { const int q = nwg / NXCD, r = nwg % NXCD, xcd = wgid % NXCD, off = wgid / NXCD; wgid = (xcd < r ? xcd * (q + 1) : r * (q + 1) + (xcd - r) * q) + off; }
        const int nig = WGM * nN, gid = wgid / nig, fm = gid * WGM, gsz = (nM - fm) < WGM ? (nM - fm) : WGM;
        u.pm = fm + ((wgid % nig) % gsz); u.pn = (wgid % nig) / gsz; u.kt0 = 0; u.nkt = 0; u.split = 0; return true;
    }
    __device__ __forceinline__ void a_ready(const Unit&) const {}
    __device__ __forceinline__ void done(const Unit&) const {}
};

__device__ __forceinline__ unsigned cvt_pk_bf16(float lo, float hi) { unsigned r; asm volatile("v_cvt_pk_bf16_f32 %0, %1, %2" : "=v"(r) : "v"(lo), "v"(hi)); return r; }
typedef float f32x2 __attribute__((ext_vector_type(2)));
__device__ __forceinline__ f32x2 gelu_pk(f32x2 v) {
    const f32x2 av = __builtin_elementwise_abs(v), d = av * 0.2316418882f + 1.0f;
    f32x2 t; t.x = __builtin_amdgcn_rcpf(d.x); t.y = __builtin_amdgcn_rcpf(d.y);
    f32x2 q = t * 0.5307027145f + (-0.7265760135f); q = q * t + 0.7107068705f; q = q * t + (-0.142248368f); q = q * t + 0.127414796f; q = q * t;
    const f32x2 s = (v * v) * (-0.72134752044f);
    f32x2 e; e.x = __builtin_amdgcn_exp2f(s.x); e.y = __builtin_amdgcn_exp2f(s.y);
    const f32x2 m = v * (q * e), r = v - m;
    f32x2 o; o.x = v.x < 0.f ? m.x : r.x; o.y = v.y < 0.f ? m.y : r.y; return o;
}

template <int ACT  > struct EpiBf16 {
    static constexpr bool PERM = true, AFTER_DRAIN = false; static_assert(ACT == 0 || ACT == 1, "EpiBf16: ACT is 0 (none) or 1 (gelu_pk)");
    bf16_t* O; int ldc; const float* bias; int split_cols; size_t split_stride; float scale0;
    __device__ __forceinline__ void operator()(const f32x4 (&acc)[2][2][4][2], const Unit& u, int wr, int wc, int fr, int fq) const {
        const int row0 = u.pm * BM + wr * 64 + fr; int colt = u.pn * BM; bf16_t* base = O;
        float sc = 1.f; if (split_cols) { const int t = colt / split_cols; base += (size_t)t * split_stride; colt -= t * split_cols; if (t == 0) sc = scale0; }
        const int col0 = colt + wc * 32 + 8 * fq, bcol0 = u.pn * BM + wc * 32 + 8 * fq;
        f32x4 bv[2][2];
#pragma unroll
        for (int bj = 0; bj < 2; ++bj)
#pragma unroll
            for (int n = 0; n < 2; ++n) bv[bj][n] = bias ? *(const f32x4*)(bias + bcol0 + bj * HALF + 4 * n) : (f32x4){0.f, 0.f, 0.f, 0.f};
#pragma unroll
        for (int ai = 0; ai < 2; ++ai)
#pragma unroll
            for (int m = 0; m < 4; ++m) { bf16_t* rowp = base + (size_t)(row0 + ai * HALF + m * 16) * ldc + col0;
#pragma unroll
                for (int bj = 0; bj < 2; ++bj) { f32x4 v0 = acc[ai][bj][m][0] + bv[bj][0], v1 = acc[ai][bj][m][1] + bv[bj][1];
                    if (ACT == 1) { f32x2 a = gelu_pk((f32x2){v0[0], v0[1]}), b = gelu_pk((f32x2){v0[2], v0[3]}), c = gelu_pk((f32x2){v1[0], v1[1]}), d = gelu_pk((f32x2){v1[2], v1[3]});
                        v0 = (f32x4){a.x, a.y, b.x, b.y}; v1 = (f32x4){c.x, c.y, d.x, d.y}; }
                    v0 = v0 * sc; v1 = v1 * sc; u32x4 w; w.x = cvt_pk_bf16(v0[0], v0[1]); w.y = cvt_pk_bf16(v0[2], v0[3]); w.z = cvt_pk_bf16(v1[0], v1[1]); w.w = cvt_pk_bf16(v1[2], v1[3]);
                    *(u32x4*)(rowp + bj * HALF) = w; } }
    }
};
template <class Epi, class Sched, bool ALIGN_EPI = false, bool SP2 = false>
__device__ __forceinline__ void gemm_phase(PG8_LAS unsigned char* lds, const Gemm g, const Sched& S, const Epi& E) {
    const int tid = threadIdx.x, wid = __builtin_amdgcn_readfirstlane(tid >> 6), lane = tid & 63, wr = wid >> 2, wc = wid & 3, fr = lane & 15, fq = lane >> 4;
    const int K = g.K;
    unsigned voffA[2], voffB[2];
#pragma unroll
    for (int i = 0; i < 2; ++i) { int R, C; stage_rc(tid * 16 + i * 8192, R, C); const int Rb = Epi::PERM ? ((R & ~31) + perm32(R & 31)) : R;
        voffA[i] = (unsigned)(R * K + C) * 2u; voffB[i] = (unsigned)(Rb * K + C) * 2u; }
    const size_t kstep = (size_t)(BK * 2);
    const size_t hstep = (size_t)HALF * K * 2;
    const size_t tstep = 2 * hstep;
    const unsigned ldsw = (unsigned)wid * 1024u;
    const int aoff = lds_byte(wr * 64 + fr, fq * 8), boff = lds_byte(wc * 32 + fr, fq * 8);
#define PG8_SA(b, h) (((b) * 2 + (h)) * HTB)
#define PG8_SB(b, h) ((4 + (b) * 2 + (h)) * HTB)
#define PG8_STAGE(bufoff, gbase, voff) do { _Pragma("unroll") for (int _i = 0; _i < 2; ++_i) \
        __builtin_amdgcn_global_load_lds((const unsigned*)((const char*)(gbase) + (voff)[_i]), (PG8_LAS unsigned*)(lds + (bufoff) + ldsw + _i * 8192), 16, 0, 0); } while (0)
#define PG8_LDA(dst, b, h) do { _Pragma("unroll") for (int m = 0; m < 4; ++m) _Pragma("unroll") for (int k = 0; k < 2; ++k) dst[m][k] = *(const PG8_LAS bf16x8*)(lds + PG8_SA(b, h) + aoff + m * 2048 + k * 1024); } while (0)
#define PG8_LDB(dst, b, h) do { _Pragma("unroll") for (int n = 0; n < 2; ++n) _Pragma("unroll") for (int k = 0; k < 2; ++k) dst[n][k] = *(const PG8_LAS bf16x8*)(lds + PG8_SB(b, h) + boff + n * 2048 + k * 1024); } while (0)
#define PG8_MMA(ai, bj, At, Bt) do { __builtin_amdgcn_s_setprio(1); _Pragma("unroll") for (int m = 0; m < 4; ++m) _Pragma("unroll") for (int n = 0; n < 2; ++n) _Pragma("unroll") for (int k = 0; k < 2; ++k) \
        acc[ai][bj][m][n] = __builtin_amdgcn_mfma_f32_16x16x32_bf16(Bt[n][k], At[m][k], acc[ai][bj][m][n], 0, 0, 0); __builtin_amdgcn_s_setprio(0); } while (0)
#define PG8_WAIT_V(n) asm volatile("s_waitcnt vmcnt(" #n ")" ::: "memory")
#define PG8_WAIT_L(n) asm volatile("s_waitcnt lgkmcnt(" #n ")" ::: "memory")
#define PG8_BAR __builtin_amdgcn_s_barrier()
#define PG8_SCHED __builtin_amdgcn_sched_barrier(0)
    Unit cur, nxt; int ui = 0;
    if (!S.next(0, cur)) return;
    if (cur.nkt == 0) { cur.kt0 = 0; cur.nkt = K / BK; }
    f32x4 acc[2][2][4][2];
#pragma unroll
    for (int a = 0; a < 2; ++a)
#pragma unroll
        for (int b = 0; b < 2; ++b)
#pragma unroll
            for (int m = 0; m < 4; ++m)
#pragma unroll
                for (int n = 0; n < 2; ++n) acc[a][b][m][n] = (f32x4){0.f, 0.f, 0.f, 0.f};
    bf16x8 At[4][2], B0[2][2], B1[2][2];
    const char* cA = (const char*)g.A + (size_t)cur.pm * tstep + (size_t)cur.kt0 * kstep; const char* cB = (const char*)g.Bt + (size_t)cur.pn * tstep + (size_t)cur.kt0 * kstep;
    S.a_ready(cur);
    if constexpr (SP2) {
        PG8_STAGE(PG8_SB(0, 0), cB, voffB); PG8_STAGE(PG8_SB(0, 1), cB + hstep, voffB); PG8_STAGE(PG8_SA(0, 0), cA, voffA); PG8_STAGE(PG8_SA(0, 1), cA + hstep, voffA);
        if (wr == 1) PG8_BAR;
        PG8_WAIT_V(2); PG8_BAR;
        PG8_STAGE(PG8_SB(1, 0), cB + kstep, voffB); PG8_STAGE(PG8_SA(1, 0), cA + kstep, voffA); PG8_STAGE(PG8_SB(1, 1), cB + hstep + kstep, voffB);
        PG8_WAIT_V(6); PG8_BAR;
    } else {
        PG8_STAGE(PG8_SB(0, 0), cB, voffB); PG8_STAGE(PG8_SA(0, 0), cA, voffA); PG8_STAGE(PG8_SB(0, 1), cB + hstep, voffB); PG8_STAGE(PG8_SA(0, 1), cA + hstep, voffA);
        if (wr == 1) PG8_BAR;
        PG8_WAIT_V(4); PG8_BAR;
        PG8_STAGE(PG8_SB(1, 0), cB + kstep, voffB); PG8_STAGE(PG8_SA(1, 0), cA + kstep, voffA); PG8_STAGE(PG8_SB(1, 1), cB + hstep + kstep, voffB);
        PG8_WAIT_V(6); PG8_BAR;
    }
    for (;;) {
        const bool has_next = S.next(ui + 1, nxt);
        if (has_next && nxt.nkt == 0) { nxt.kt0 = 0; nxt.nkt = K / BK; }
        const int nt = cur.nkt;
        const char* nA = has_next ? (const char*)g.A + (size_t)nxt.pm * tstep + (size_t)nxt.kt0 * kstep : cA; const char* nB = has_next ? (const char*)g.Bt + (size_t)nxt.pn * tstep + (size_t)nxt.kt0 * kstep : cB;
        for (int t = 0; t < nt; t += 2) {
            const bool last = (t == nt - 2);
            const char* a1 = cA + (size_t)(t + 1) * kstep;
            const char* a2 = last ? nA : cA + (size_t)(t + 2) * kstep; const char* b2 = last ? nB : cB + (size_t)(t + 2) * kstep;
            const char* a3 = a2 + kstep; const char* b3 = b2 + kstep;
            if (last && has_next) S.a_ready(nxt);
            if constexpr (SP2) {
            PG8_LDB(B0, 0, 0); PG8_LDB(B1, 0, 1); PG8_SCHED; PG8_LDA(At, 0, 0); PG8_STAGE(PG8_SA(1, 1), a1 + hstep, voffA);
            PG8_WAIT_V(8); PG8_WAIT_L(0); PG8_BAR; PG8_MMA(0, 0, At, B0); PG8_MMA(0, 1, At, B1); PG8_BAR; PG8_SCHED;
            PG8_LDA(At, 0, 1); PG8_STAGE(PG8_SB(0, 0), b2, voffB); PG8_STAGE(PG8_SB(0, 1), b2 + hstep, voffB); PG8_STAGE(PG8_SA(0, 0), a2, voffA);
            PG8_WAIT_V(8); PG8_WAIT_L(0); PG8_BAR; PG8_MMA(1, 0, At, B0); PG8_MMA(1, 1, At, B1); PG8_BAR; PG8_SCHED;
            PG8_LDB(B0, 1, 0); PG8_LDB(B1, 1, 1); PG8_SCHED; PG8_LDA(At, 1, 0); PG8_STAGE(PG8_SA(0, 1), a2 + hstep, voffA);
            PG8_WAIT_V(8); PG8_WAIT_L(0); PG8_BAR; PG8_MMA(0, 0, At, B0); PG8_MMA(0, 1, At, B1); PG8_BAR; PG8_SCHED;
            PG8_LDA(At, 1, 1); PG8_STAGE(PG8_SB(1, 0), b3, voffB); PG8_STAGE(PG8_SB(1, 1), b3 + hstep, voffB); PG8_STAGE(PG8_SA(1, 0), a3, voffA);
            PG8_WAIT_V(8); PG8_WAIT_L(0); PG8_BAR; PG8_MMA(1, 0, At, B0); PG8_MMA(1, 1, At, B1); PG8_BAR; PG8_SCHED;
            } else {
            PG8_LDB(B0, 0, 0); PG8_SCHED; PG8_LDA(At, 0, 0); PG8_STAGE(PG8_SA(1, 1), a1 + hstep, voffA);
            PG8_WAIT_L(8); PG8_BAR; PG8_WAIT_L(0); PG8_MMA(0, 0, At, B0); PG8_BAR; PG8_SCHED;
            PG8_LDB(B1, 0, 1); PG8_STAGE(PG8_SB(0, 0), b2, voffB);
            PG8_BAR; PG8_WAIT_L(0); PG8_MMA(0, 1, At, B1); PG8_BAR;
            PG8_LDA(At, 0, 1); PG8_STAGE(PG8_SA(0, 0), a2, voffA);
            PG8_BAR; PG8_WAIT_L(0); PG8_MMA(1, 0, At, B0); PG8_BAR; PG8_SCHED;
            PG8_STAGE(PG8_SB(0, 1), b2 + hstep, voffB);
            PG8_WAIT_V(6); PG8_BAR; PG8_MMA(1, 1, At, B1); PG8_BAR;
            PG8_LDB(B0, 1, 0); PG8_SCHED; PG8_LDA(At, 1, 0); PG8_STAGE(PG8_SA(0, 1), a2 + hstep, voffA);
            PG8_WAIT_L(8); PG8_BAR; PG8_WAIT_L(0); PG8_MMA(0, 0, At, B0); PG8_BAR; PG8_SCHED;
            PG8_LDB(B1, 1, 1); PG8_STAGE(PG8_SB(1, 0), b3, voffB);
            PG8_BAR; PG8_WAIT_L(0); PG8_MMA(0, 1, At, B1); PG8_BAR;
            PG8_LDA(At, 1, 1); PG8_STAGE(PG8_SA(1, 0), a3, voffA);
            PG8_BAR; PG8_WAIT_L(0); PG8_MMA(1, 0, At, B0); PG8_BAR; PG8_SCHED;
            PG8_STAGE(PG8_SB(1, 1), b3 + hstep, voffB);
            PG8_WAIT_V(6); PG8_BAR; PG8_MMA(1, 1, At, B1); PG8_BAR;
            }
        }
        if constexpr (ALIGN_EPI) { if (wr == 0) PG8_BAR; }
        if constexpr (!Epi::AFTER_DRAIN) { E(acc, cur, wr, wc, fr, fq); S.done(cur); }
        if (!has_next) break;
#pragma unroll
        for (int a = 0; a < 2; ++a)
#pragma unroll
            for (int b = 0; b < 2; ++b)
#pragma unroll
                for (int m = 0; m < 4; ++m)
#pragma unroll
                    for (int n = 0; n < 2; ++n) acc[a][b][m][n] = (f32x4){0.f, 0.f, 0.f, 0.f};
        cur = nxt; cA = nA; cB = nB; ++ui;
        if constexpr (ALIGN_EPI) { if (wr == 1) PG8_BAR; }
    }
    PG8_WAIT_V(0);
    if constexpr (!ALIGN_EPI) { if (wr == 0) PG8_BAR; }
    PG8_BAR;
    if constexpr (Epi::AFTER_DRAIN) { E.fused(acc, cur, wr, wc, fr, fq, lds, wid, lane); S.done(cur); }
#undef PG8_SA
#undef PG8_SB
#undef PG8_STAGE
#undef PG8_LDA
#undef PG8_LDB
#undef PG8_MMA
#undef PG8_WAIT_V
#undef PG8_WAIT_L
#undef PG8_BAR
#undef PG8_SCHED
}
}

namespace pg8 {
struct EpiRes {
    static constexpr bool PERM = true, AFTER_DRAIN = false;
    const float* xp; const float* xs; float* out; bf16_t* xb; float* ss; float* part;
    __device__ __forceinline__ void operator()(const f32x4 (&acc)[2][2][4][2], const Unit& u, int wr, int wc, int fr, int fq) const {
        if (u.split) {
#pragma unroll
            for (int ai = 0; ai < 2; ++ai)
#pragma unroll
                for (int m = 0; m < 4; ++m) {
                    const int row = u.pm * BM + ai * HALF + wr * 64 + m * 16 + fr;
#pragma unroll
                    for (int bj = 0; bj < 2; ++bj) {
                        const int col = u.pn * BM + bj * HALF + wc * 32 + 8 * fq;
                        float* o = part + ((size_t)(u.split - 1) * 1024 + (row - 8192)) * 2048 + col;
                        *(f32x4*)o = acc[ai][bj][m][0]; *(f32x4*)(o + 4) = acc[ai][bj][m][1];
                    }
                }
            return;
        }
#pragma unroll
        for (int ai = 0; ai < 2; ++ai)
#pragma unroll
            for (int m = 0; m < 4; ++m) {
                const int row = u.pm * BM + ai * HALF + wr * 64 + m * 16 + fr;
                const float* src = row < 8192 ? xp + (size_t)row * 2048 : xs + (size_t)(row - 8192) * 2048;
                float s = 0.f;
#pragma unroll
                for (int bj = 0; bj < 2; ++bj) {
                    const int col = u.pn * BM + bj * HALF + wc * 32 + 8 * fq;
                    const f32x4 a0 = *(const f32x4*)(src + col), a1 = *(const f32x4*)(src + col + 4);
                    const f32x4 v0 = acc[ai][bj][m][0] + a0, v1 = acc[ai][bj][m][1] + a1;
                    *(f32x4*)(out + (size_t)row * 2048 + col) = v0; *(f32x4*)(out + (size_t)row * 2048 + col + 4) = v1;
                    if (xb) { u32x4 w; w.x = cvt_pk_bf16(v0[0], v0[1]); w.y = cvt_pk_bf16(v0[2], v0[3]); w.z = cvt_pk_bf16(v1[0], v1[1]); w.w = cvt_pk_bf16(v1[2], v1[3]);
                        *(u32x4*)(xb + (size_t)row * 2048 + col) = w; }
                    s += (v0[0] * v0[0] + v0[1] * v0[1]) + (v0[2] * v0[2] + v0[3] * v0[3]) + (v1[0] * v1[0] + v1[1] * v1[1]) + (v1[2] * v1[2] + v1[3] * v1[3]);
                }
                if (ss) { s += __shfl_xor(s, 16); s += __shfl_xor(s, 32); if (fq == 0) unsafeAtomicAdd(ss + row, s); }
            }
    }
};

struct SplitOrder {
    StaticOrder full; int G, c, a, b; bool on;
    __host__ __device__ void init(int N, int G_, int c_, int a_, int b_) { G = G_; c = c_; a = a_; b = b_; on = (G_ == 256); full.init(on ? 8192 : 9216, N, G_, c_); }
    __host__ __device__ bool next(int i, Unit& u) const {
        if (!on || i == 0) return full.next(i, u);
        if (i > 1) return false;
        const int su = c >> 3, p = c & 7;
        u.pm = 32 + (su >> 3); u.pn = su & 7; u.kt0 = p < 4 ? a * p : 4 * a + b * (p - 4); u.nkt = p < 4 ? a : b; u.split = 1 + p; return true;
    }
    __device__ __forceinline__ void a_ready(const Unit&) const {}
    __device__ __forceinline__ void done(const Unit&) const {}
};

__device__ __forceinline__ float silu_f(float a) { return a * __builtin_amdgcn_rcpf(1.0f + __expf(-a)); }

struct EpiGU {
    static constexpr bool PERM = true, AFTER_DRAIN = false;
    bf16_t* HM; const float* ss1; const float* cw; const float* cb; const float* st;
    float* SG; float* SU; float* TG; float* ffp; float* ffs;
    __device__ __forceinline__ void operator()(const f32x4 (&acc)[2][2][4][2], const Unit& u, int wr, int wc, int fr, int fq) const {
        const int lane = fq * 16 + fr;
        const int col = u.pn * 128 + wc * 32 + 8 * fq;
        const int src1 = (lane & 48) | ((fr - 1) & 15), src2 = (lane & 48) | ((fr - 2) & 15);
        float w0[8], w1[8], w2[8], bb[8];
#pragma unroll
        for (int e = 0; e < 8; ++e) { w0[e] = cw[col + e]; w1[e] = cw[5632 + col + e]; w2[e] = cw[2 * 5632 + col + e]; bb[e] = cb[col + e]; }
        const bool samp = u.pm >= 32;
#pragma unroll
        for (int ai = 0; ai < 2; ++ai) {
            const int rb = u.pm * BM + ai * HALF + wr * 64, blk = rb >> 6;
            float r1p[8], r2p[8];
#pragma unroll
            for (int e = 0; e < 8; ++e) { r1p[e] = 0.f; r2p[e] = 0.f; }
#pragma unroll
            for (int m = 0; m < 4; ++m) {
                const int row = rb + 16 * m + fr;
                const float rs = rsqrtf(ss1[row] * (1.0f / 2048.0f) + 1e-6f);
                float g[8], up[8], r1[8], r2[8], p1[8], p2[8];
#pragma unroll
                for (int n = 0; n < 2; ++n)
#pragma unroll
                    for (int j = 0; j < 4; ++j) { g[4 * n + j] = acc[ai][0][m][n][j] * rs; up[4 * n + j] = acc[ai][1][m][n][j] * rs; }
#pragma unroll
                for (int e = 0; e < 8; ++e) { r1[e] = __shfl(g[e], src1); r2[e] = __shfl(g[e], src2); }
                bool do_store = true;
                if (!samp) {
#pragma unroll
                    for (int e = 0; e < 8; ++e) { p1[e] = fr >= 1 ? r1[e] : r1p[e]; p2[e] = fr >= 2 ? r2[e] : r2p[e]; }
                    if (m == 0 && fr < 2) {
                        float* sg = SG + (size_t)(blk * 2 + fr) * 5632 + col; float* su = SU + (size_t)(blk * 2 + fr) * 5632 + col;
                        *(f32x4*)sg = (f32x4){g[0], g[1], g[2], g[3]}; *(f32x4*)(sg + 4) = (f32x4){g[4], g[5], g[6], g[7]};
                        *(f32x4*)su = (f32x4){up[0], up[1], up[2], up[3]}; *(f32x4*)(su + 4) = (f32x4){up[4], up[5], up[6], up[7]};
                        do_store = false;
                    }
                    if (m == 3 && fr >= 14) {
                        float* tg = TG + (size_t)(blk * 2 + fr - 14) * 5632 + col;
                        *(f32x4*)tg = (f32x4){g[0], g[1], g[2], g[3]}; *(f32x4*)(tg + 4) = (f32x4){g[4], g[5], g[6], g[7]};
                        if ((blk & 31) == 31) { float* fo = ffp + (size_t)((blk >> 5) * 2 + fr - 14) * 5632 + col;
                            *(f32x4*)fo = (f32x4){g[0], g[1], g[2], g[3]}; *(f32x4*)(fo + 4) = (f32x4){g[4], g[5], g[6], g[7]}; }
                    }
                } else {
                    const int t = fr & 7, b = (row - 8192) >> 3;
                    float s0[8], s1[8];
#pragma unroll
                    for (int e = 0; e < 8; ++e) { s0[e] = 0.f; s1[e] = 0.f; }
                    if (t < 2) {
                        const float* sp = st + (size_t)(b * 2) * 5632 + col;
#pragma unroll
                        for (int e = 0; e < 8; ++e) { s0[e] = sp[e]; s1[e] = sp[5632 + e]; }
                    }
#pragma unroll
                    for (int e = 0; e < 8; ++e) { p1[e] = t >= 1 ? r1[e] : s1[e]; p2[e] = t >= 2 ? r2[e] : (t == 1 ? s1[e] : s0[e]); }
                    if (t >= 6) { float* fo = ffs + (size_t)(b * 2 + t - 6) * 5632 + col;
                        *(f32x4*)fo = (f32x4){g[0], g[1], g[2], g[3]}; *(f32x4*)(fo + 4) = (f32x4){g[4], g[5], g[6], g[7]}; }
                }
                if (do_store) {
                    float h[8];
#pragma unroll
                    for (int e = 0; e < 8; ++e) { const float a = w0[e] * p2[e] + w1[e] * p1[e] + w2[e] * g[e] + bb[e]; h[e] = silu_f(a) * up[e]; }
                    u32x4 w; w.x = cvt_pk_bf16(h[0], h[1]); w.y = cvt_pk_bf16(h[2], h[3]); w.z = cvt_pk_bf16(h[4], h[5]); w.w = cvt_pk_bf16(h[6], h[7]);
                    *(u32x4*)(HM + (size_t)row * 5632 + col) = w;
                }
#pragma unroll
                for (int e = 0; e < 8; ++e) { r1p[e] = r1[e]; r2p[e] = r2[e]; }
            }
        }
    }
};
}

#define LAS __attribute__((address_space(3)))
typedef unsigned short bf16;
typedef unsigned v4u __attribute__((ext_vector_type(4)));
typedef unsigned v2u __attribute__((ext_vector_type(2)));
typedef float f32x4 __attribute__((ext_vector_type(4)));
typedef short bf16x8 __attribute__((ext_vector_type(8)));

constexpr int DM = 2048, MP = 8192, MS = 1024, MT = 9216, SEQ = 2048, NIN = 4608, DFF = 5632;
constexpr int QK_OFF = 1024, QV_OFF = 1280, QB_OFF = 1536, QC_OFF = 2560, QU_OFF = 3584;
constexpr int NWAVES = 8, NTHR = 512;
constexpr int LDS_BYTES = 147456;
constexpr float EPS = 1e-6f;

constexpr size_t O_Y = 0, O_KWP = 18874368, O_VWP = 19005440, O_CVP = 19136512, O_FFP = 19144704,
                 O_KWS = 19189760, O_VWS = 23384064, O_CVS = 27578368, O_FFS = 27840512, O_END = 29282304;
constexpr size_t MiB = 1u << 20;
constexpr size_t WS_SS1 = 0;
constexpr size_t WS_BAR = 65536, CTL_ZERO_BYTES = 131072;
constexpr int LDS_XB_OFF = 131072 + 64;
constexpr size_t WS_WIN = 1 * MiB;
constexpr size_t WS_WOUT = 19 * MiB;
constexpr size_t WS_WGU = 27 * MiB;
constexpr size_t WS_WDN = 71 * MiB;
constexpr size_t WS_H = 93 * MiB;
constexpr size_t WS_MIX = 129 * MiB;
constexpr size_t WS_QKV = 165 * MiB;
constexpr size_t WS_ATT = 246 * MiB;
constexpr size_t WS_HM = 165 * MiB;
constexpr size_t WS_SG = 264 * MiB, WS_SU = 271 * MiB, WS_TG = 278 * MiB, WS_END = 285 * MiB;

struct Args { const float* in[20]; float* out; unsigned char* ws; int ph_lo, ph_hi; };

__device__ __forceinline__ unsigned f2bf(float f) { unsigned u = __builtin_bit_cast(unsigned, f); return (u + 0x7fffu + ((u >> 16) & 1u)) >> 16; }
__device__ __forceinline__ unsigned pk2(float lo, float hi) { return pg8::cvt_pk_bf16(lo, hi); }
__device__ __forceinline__ float bflo(unsigned w) { return __builtin_bit_cast(float, w << 16); }
__device__ __forceinline__ float bfhi(unsigned w) { return __builtin_bit_cast(float, w & 0xffff0000u); }
__device__ __forceinline__ float wave_sum(float v) {
#pragma unroll
    for (int o = 1; o < 64; o <<= 1) v += __shfl_xor(v, o);
    return v;
}
#define LDS_WAIT() asm volatile("s_waitcnt lgkmcnt(0)" ::: "memory")

template <int MODE>
__device__ __forceinline__ void p0_transpose_item(const float* W, int K, int N, bf16* WT, const float* kscale, LAS float* scr, int item, int lane) {
    const int nblk = N / 32, kb = item / nblk, nb = item % nblk, k0 = 64 * kb, n0 = 32 * nb;
    f32x4 v[8];
#pragma unroll
    for (int i = 0; i < 8; ++i) v[i] = *(const f32x4*)(W + (size_t)(k0 + 8 * i + (lane >> 3)) * N + n0 + 4 * (lane & 7));
#pragma unroll
    for (int i = 0; i < 8; ++i) { const int kk = 8 * i + (lane >> 3); f32x4 x = v[i]; if (kscale) x = x * kscale[k0 + kk];
        LAS float* d = scr + kk * 33 + 4 * (lane & 7); d[0] = x.x; d[1] = x.y; d[2] = x.z; d[3] = x.w; }
    LDS_WAIT(); asm volatile("" ::: "memory");
    const int c = lane & 7;
#pragma unroll
    for (int j = 0; j < 4; ++j) { const int n = (lane >> 3) + 8 * j; const LAS float* s = scr + (8 * c) * 33 + n;
        v4u o; o.x = pk2(s[0 * 33], s[1 * 33]); o.y = pk2(s[2 * 33], s[3 * 33]); o.z = pk2(s[4 * 33], s[5 * 33]); o.w = pk2(s[6 * 33], s[7 * 33]);
        const int nn = n0 + n; const int drow = MODE == 0 ? nn : ((nn >> 7) * 256 + (MODE - 1) * 128 + (nn & 127));
        *(v4u*)(WT + (size_t)drow * K + k0 + 8 * c) = o; }
    LDS_WAIT(); asm volatile("" ::: "memory");
}

__device__ __forceinline__ void rms_row_to_bf16(const float* xrow, const float* g, bf16* orow, int lane) {
    const f32x4* xr = (const f32x4*)xrow + lane; const f32x4* gr = (const f32x4*)g + lane;
    f32x4 v[8]; float s = 0.f;
#pragma unroll
    for (int j = 0; j < 8; ++j) { v[j] = xr[64 * j]; s += (v[j].x * v[j].x + v[j].y * v[j].y) + (v[j].z * v[j].z + v[j].w * v[j].w); }
    const float rs = rsqrtf(wave_sum(s) * (1.0f / 2048.0f) + EPS);
    v2u* o8 = (v2u*)orow + lane;
#pragma unroll
    for (int j = 0; j < 8; ++j) { const f32x4 gg = gr[64 * j]; v2u o; o.x = pk2(v[j].x * rs * gg.x, v[j].y * rs * gg.y); o.y = pk2(v[j].z * rs * gg.z, v[j].w * rs * gg.w); o8[64 * j] = o; }
}

constexpr int KS_PITCH = 144, VT_PITCH = 560, KS_BYTES = 272 * KS_PITCH, VT_OFF = KS_BYTES;

__device__ __forceinline__ void attn_job(const LAS unsigned char* Ks, const LAS unsigned char* Vt, const bf16* qptr, float slope, float sink,
                                         int qpos, int jt0, int keymin, bf16* optr, int lane) {
    const int c = lane & 15, g = lane >> 4;
    bf16x8 qf[2];
#pragma unroll
    for (int ks = 0; ks < 2; ++ks) qf[ks] = *(const bf16x8*)(qptr + 32 * ks + 8 * g);
    f32x4 o[4];
#pragma unroll
    for (int dt = 0; dt < 4; ++dt) o[dt] = (f32x4){0.f, 0.f, 0.f, 0.f};
    float mx = sink, sum = 0.f;
#pragma unroll 1
    for (int s = 0; s < 5; ++s) {
        const int jt = jt0 + 2 * s;
        f32x4 st[2];
#pragma unroll
        for (int t = 0; t < 2; ++t) {
            f32x4 a = (f32x4){0.f, 0.f, 0.f, 0.f};
#pragma unroll
            for (int ks = 0; ks < 2; ++ks) {
                const bf16x8 kf = *(const LAS bf16x8*)(Ks + (16 * (jt + t) + c) * KS_PITCH + (32 * ks + 8 * g) * 2);
                a = __builtin_amdgcn_mfma_f32_16x16x32_bf16(kf, qf[ks], a, 0, 0, 0);
            }
            st[t] = a;
        }
        float lm = -1e30f;
#pragma unroll
        for (int t = 0; t < 2; ++t)
#pragma unroll
            for (int i = 0; i < 4; ++i) {
                const int key = 16 * (jt + t) + 4 * g + i, dist = qpos - key;
                const bool valid = dist >= 0 && dist <= 128 && key >= keymin;
                const float sc = valid ? st[t][i] * 0.125f - slope * (float)dist : -1e30f;
                st[t][i] = sc; lm = fmaxf(lm, sc);
            }
        lm = fmaxf(lm, __shfl_xor(lm, 16)); lm = fmaxf(lm, __shfl_xor(lm, 32));
        const float mn = fmaxf(mx, lm), alpha = __expf(mx - mn);
        mx = mn; sum *= alpha;
#pragma unroll
        for (int dt = 0; dt < 4; ++dt) o[dt] = o[dt] * alpha;
#pragma unroll
        for (int t = 0; t < 2; ++t)
#pragma unroll
            for (int i = 0; i < 4; ++i) { const float p = __expf(st[t][i] - mn); st[t][i] = p; sum += p; }
        v4u pw; pw.x = pk2(st[0][0], st[0][1]); pw.y = pk2(st[0][2], st[0][3]); pw.z = pk2(st[1][0], st[1][1]); pw.w = pk2(st[1][2], st[1][3]);
        const bf16x8 pb = __builtin_bit_cast(bf16x8, pw);
#pragma unroll
        for (int dt = 0; dt < 4; ++dt) {
            const LAS unsigned char* vp = Vt + (16 * dt + c) * VT_PITCH + (16 * jt + 4 * g) * 2;
            const v2u lo = *(const LAS v2u*)vp, hi = *(const LAS v2u*)(vp + 32);
            v4u vw; vw.x = lo.x; vw.y = lo.y; vw.z = hi.x; vw.w = hi.y;
            o[dt] = __builtin_amdgcn_mfma_f32_16x16x32_bf16(__builtin_bit_cast(bf16x8, vw), pb, o[dt], 0, 0, 0);
        }
    }
    sum += __shfl_xor(sum, 16); sum += __shfl_xor(sum, 32); sum += __expf(sink - mx);
    const float inv = 1.0f / sum;
#pragma unroll
    for (int dt = 0; dt < 4; ++dt) { v2u w; w.x = pk2(o[dt][0] * inv, o[dt][1] * inv); w.y = pk2(o[dt][2] * inv, o[dt][3] * inv); *(v2u*)(optr + 16 * dt + 4 * g) = w; }
}

__device__ __forceinline__ void attn_phase(const Args& a, LAS unsigned char* lds, int tid, int lane, int wave) {
    const bf16* QKV = (const bf16*)(a.ws + WS_QKV); bf16* ATT = (bf16*)(a.ws + WS_ATT);
    const float* cache_k = a.in[2]; const float* cache_v = a.in[3]; const float* sinks = a.in[8];
    float* out = a.out;
    LAS unsigned char* Ks = lds; LAS unsigned char* Vt = lds + VT_OFF;
    const int c = lane & 15;
    for (int unit = blockIdx.x; unit < 768; unit += gridDim.x) {
        __syncthreads();
        if (unit < 256) {
            const int b = unit >> 6, nb = (unit >> 2) & 15, kvh = unit & 3;
#pragma unroll 1
            for (int ch = tid; ch < 272 * 8; ch += NTHR) {
                const int j = ch >> 3, part = ch & 7, tok = (nb - 1) * 128 + j;
                v4u kk = (v4u){0u, 0u, 0u, 0u}, vv = (v4u){0u, 0u, 0u, 0u};
                if (j < 256 && tok >= 0) {
                    const bf16* src = QKV + (size_t)(b * SEQ + tok) * NIN + QK_OFF + kvh * 64 + part * 8;
                    kk = *(const v4u*)src; vv = *(const v4u*)(src + 256);
                    if (nb == 15 && j >= 128) {
                        float* ko = out + O_KWP + ((size_t)(b * 128 + j - 128) * 4 + kvh) * 64 + part * 8; float* vo = out + O_VWP + ((size_t)(b * 128 + j - 128) * 4 + kvh) * 64 + part * 8;
                        *(f32x4*)ko = (f32x4){bflo(kk.x), bfhi(kk.x), bflo(kk.y), bfhi(kk.y)}; *(f32x4*)(ko + 4) = (f32x4){bflo(kk.z), bfhi(kk.z), bflo(kk.w), bfhi(kk.w)};
                        *(f32x4*)vo = (f32x4){bflo(vv.x), bfhi(vv.x), bflo(vv.y), bfhi(vv.y)}; *(f32x4*)(vo + 4) = (f32x4){bflo(vv.z), bfhi(vv.z), bflo(vv.w), bfhi(vv.w)};
                    }
                }
                *(LAS v4u*)(Ks + j * KS_PITCH + part * 16) = kk;
                LAS unsigned short* vt = (LAS unsigned short*)(Vt + (part * 8) * VT_PITCH + j * 2);
                vt[0 * (VT_PITCH / 2)] = (unsigned short)(vv.x & 0xffffu); vt[1 * (VT_PITCH / 2)] = (unsigned short)(vv.x >> 16);
                vt[2 * (VT_PITCH / 2)] = (unsigned short)(vv.y & 0xffffu); vt[3 * (VT_PITCH / 2)] = (unsigned short)(vv.y >> 16);
                vt[4 * (VT_PITCH / 2)] = (unsigned short)(vv.z & 0xffffu); vt[5 * (VT_PITCH / 2)] = (unsigned short)(vv.z >> 16);
                vt[6 * (VT_PITCH / 2)] = (unsigned short)(vv.w & 0xffffu); vt[7 * (VT_PITCH / 2)] = (unsigned short)(vv.w >> 16);
            }
            __syncthreads();
            const int rt = wave;
            const size_t qrow = (size_t)(b * SEQ + nb * 128 + 16 * rt + c);
#pragma unroll 1
            for (int hq = 0; hq < 4; ++hq) {
                const int h = kvh * 4 + hq;
                const float slope = exp2f(-0.5f * (float)(h + 1)), sink = sinks[h];
                attn_job(Ks, Vt, QKV + qrow * NIN + h * 64, slope, sink, 16 * rt + c + 128, rt, nb > 0 ? 0 : 128, ATT + qrow * 1024 + h * 64, lane);
            }
        } else {
            const int su = unit - 256, b = su >> 2, kvh = su & 3;
#pragma unroll 1
            for (int ch = tid; ch < 160 * 8; ch += NTHR) {
                const int j = ch >> 3, part = ch & 7;
                v4u kk = (v4u){0u, 0u, 0u, 0u}, vv = (v4u){0u, 0u, 0u, 0u};
                if (j < 128) {
                    const size_t off = ((size_t)(b * 128 + j) * 4 + kvh) * 64 + part * 8;
                    const f32x4 k0 = *(const f32x4*)(cache_k + off), k1 = *(const f32x4*)(cache_k + off + 4), v0 = *(const f32x4*)(cache_v + off), v1 = *(const f32x4*)(cache_v + off + 4);
                    kk.x = pk2(k0.x, k0.y); kk.y = pk2(k0.z, k0.w); kk.z = pk2(k1.x, k1.y); kk.w = pk2(k1.z, k1.w);
                    vv.x = pk2(v0.x, v0.y); vv.y = pk2(v0.z, v0.w); vv.z = pk2(v1.x, v1.y); vv.w = pk2(v1.z, v1.w);
                    if (j >= 8) { const size_t oo = ((size_t)(b * 128 + j - 8) * 4 + kvh) * 64 + part * 8;
                        *(f32x4*)(out + O_KWS + oo) = k0; *(f32x4*)(out + O_KWS + oo + 4) = k1; *(f32x4*)(out + O_VWS + oo) = v0; *(f32x4*)(out + O_VWS + oo + 4) = v1; }
                } else if (j < 136) {
                    const bf16* src = QKV + (size_t)(MP + b * 8 + j - 128) * NIN + QK_OFF + kvh * 64 + part * 8;
                    kk = *(const v4u*)src; vv = *(const v4u*)(src + 256);
                    const size_t oo = ((size_t)(b * 128 + j - 8) * 4 + kvh) * 64 + part * 8;
                    float* ko = out + O_KWS + oo; float* vo = out + O_VWS + oo;
                    *(f32x4*)ko = (f32x4){bflo(kk.x), bfhi(kk.x), bflo(kk.y), bfhi(kk.y)}; *(f32x4*)(ko + 4) = (f32x4){bflo(kk.z), bfhi(kk.z), bflo(kk.w), bfhi(kk.w)};
                    *(f32x4*)vo = (f32x4){bflo(vv.x), bfhi(vv.x), bflo(vv.y), bfhi(vv.y)}; *(f32x4*)(vo + 4) = (f32x4){bflo(vv.z), bfhi(vv.z), bflo(vv.w), bfhi(vv.w)};
                }
                *(LAS v4u*)(Ks + j * KS_PITCH + part * 16) = kk;
                LAS unsigned short* vt = (LAS unsigned short*)(Vt + (part * 8) * VT_PITCH + j * 2);
                vt[0 * (VT_PITCH / 2)] = (unsigned short)(vv.x & 0xffffu); vt[1 * (VT_PITCH / 2)] = (unsigned short)(vv.x >> 16);
                vt[2 * (VT_PITCH / 2)] = (unsigned short)(vv.y & 0xffffu); vt[3 * (VT_PITCH / 2)] = (unsigned short)(vv.y >> 16);
                vt[4 * (VT_PITCH / 2)] = (unsigned short)(vv.z & 0xffffu); vt[5 * (VT_PITCH / 2)] = (unsigned short)(vv.z >> 16);
                vt[6 * (VT_PITCH / 2)] = (unsigned short)(vv.w & 0xffffu); vt[7 * (VT_PITCH / 2)] = (unsigned short)(vv.w >> 16);
            }
            __syncthreads();
            if (wave < 2) {
                const int qi = c & 7, h = kvh * 4 + 2 * wave + (c >> 3);
                const float slope = exp2f(-0.5f * (float)(h + 1)), sink = sinks[h];
                const size_t qrow = (size_t)(MP + b * 8 + qi);
                attn_job(Ks, Vt, QKV + qrow * NIN + h * 64, slope, sink, qi + 128, 0, 0, ATT + qrow * 1024 + h * 64, lane);
            }
        }
    }
}

__device__ __forceinline__ void load16bf(const bf16* p, float (&f)[16]) {
    const v4u a = *(const v4u*)p, b = *(const v4u*)(p + 8);
    f[0] = bflo(a.x); f[1] = bfhi(a.x); f[2] = bflo(a.y); f[3] = bfhi(a.y); f[4] = bflo(a.z); f[5] = bfhi(a.z); f[6] = bflo(a.w); f[7] = bfhi(a.w);
    f[8] = bflo(b.x); f[9] = bfhi(b.x); f[10] = bflo(b.y); f[11] = bfhi(b.y); f[12] = bflo(b.z); f[13] = bfhi(b.z); f[14] = bflo(b.w); f[15] = bfhi(b.w);
}
__device__ __forceinline__ void store16bf(bf16* p, const float (&f)[16]) {
    v4u a, b; a.x = pk2(f[0], f[1]); a.y = pk2(f[2], f[3]); a.z = pk2(f[4], f[5]); a.w = pk2(f[6], f[7]); b.x = pk2(f[8], f[9]); b.y = pk2(f[10], f[11]); b.z = pk2(f[12], f[13]); b.w = pk2(f[14], f[15]);
    *(v4u*)p = a; *(v4u*)(p + 8) = b;
}
__device__ __forceinline__ void load16f(const float* p, float (&f)[16]) {
#pragma unroll
    for (int q = 0; q < 4; ++q) { const f32x4 v = *(const f32x4*)(p + 4 * q); f[4 * q] = v.x; f[4 * q + 1] = v.y; f[4 * q + 2] = v.z; f[4 * q + 3] = v.w; }
}
__device__ __forceinline__ void store16f(float* p, const float (&f)[16]) {
#pragma unroll
    for (int q = 0; q < 4; ++q) *(f32x4*)(p + 4 * q) = (f32x4){f[4 * q], f[4 * q + 1], f[4 * q + 2], f[4 * q + 3]};
}
__device__ __forceinline__ void mix_row(const Args& a, int r, int lane) {
    const bf16* QKV = (const bf16*)(a.ws + WS_QKV); const bf16* ATT = (const bf16*)(a.ws + WS_ATT); bf16* MIX = (bf16*)(a.ws + WS_MIX);
    const float* state_conv = a.in[4]; const float* conv_w = a.in[9]; const float* gA = a.in[10]; const float* gB = a.in[11];
    const int c0 = lane * 16;
    float x[16], gg[16];
    load16bf(ATT + (size_t)r * 1024 + c0, x);
    float s = 0.f;
#pragma unroll
    for (int e = 0; e < 16; ++e) s += x[e] * x[e];
    float rs = rsqrtf(wave_sum(s) * (1.0f / 1024.0f) + EPS);
    load16f(gA + c0, gg);
#pragma unroll
    for (int e = 0; e < 16; ++e) x[e] = x[e] * rs * gg[e];
    store16bf(MIX + (size_t)r * 2048 + c0, x);
    float Bv[16], Cv[16], Uv[16], cu[16], p1[16], p2[16], w0[16], w1[16], w2[16];
    const bf16* qr = QKV + (size_t)r * NIN;
    load16bf(qr + QB_OFF + c0, Bv); load16bf(qr + QC_OFF + c0, Cv); load16bf(qr + QU_OFF + c0, Uv);
#pragma unroll
    for (int e = 0; e < 16; ++e) { cu[e] = Cv[e] * Uv[e]; p1[e] = 0.f; p2[e] = 0.f; }
    int t, nseq; float* cs_out;
    if (r < MP) { t = r & (SEQ - 1); nseq = SEQ; cs_out = a.out + O_CVP + (size_t)((r >> 11) * 2) * 1024 + c0; }
    else { t = (r - MP) & 7; nseq = 8; cs_out = a.out + O_CVS + (size_t)(((r - MP) >> 3) * 2) * 1024 + c0; }
    if (t >= 1) { load16bf(qr - NIN + QC_OFF + c0, Cv); load16bf(qr - NIN + QU_OFF + c0, Uv);
#pragma unroll
        for (int e = 0; e < 16; ++e) p1[e] = Cv[e] * Uv[e]; }
    else if (r >= MP) load16f(state_conv + (size_t)(((r - MP) >> 3) * 2 + 1) * 1024 + c0, p1);
    if (t >= 2) { load16bf(qr - 2 * NIN + QC_OFF + c0, Cv); load16bf(qr - 2 * NIN + QU_OFF + c0, Uv);
#pragma unroll
        for (int e = 0; e < 16; ++e) p2[e] = Cv[e] * Uv[e]; }
    else if (r >= MP) load16f(state_conv + (size_t)(((r - MP) >> 3) * 2 + t) * 1024 + c0, p2);
    if (t >= nseq - 2) store16f(cs_out + (size_t)(t - (nseq - 2)) * 1024, cu);
    load16f(conv_w + c0, w0); load16f(conv_w + 1024 + c0, w1); load16f(conv_w + 2048 + c0, w2);
    s = 0.f;
#pragma unroll
    for (int e = 0; e < 16; ++e) { x[e] = Bv[e] * (w0[e] * p2[e] + w1[e] * p1[e] + w2[e] * cu[e]); s += x[e] * x[e]; }
    rs = rsqrtf(wave_sum(s) * (1.0f / 1024.0f) + EPS);
    load16f(gB + c0, gg);
#pragma unroll
    for (int e = 0; e < 16; ++e) x[e] = x[e] * rs * gg[e];
    store16bf(MIX + (size_t)r * 2048 + 1024 + c0, x);
}

__device__ __forceinline__ void fixup_phase(const Args& a, int gtid, int gthreads) {
    const float* SG = (const float*)(a.ws + WS_SG); const float* SU = (const float*)(a.ws + WS_SU); const float* TG = (const float*)(a.ws + WS_TG);
    const float* cw = a.in[16]; const float* cb = a.in[17]; bf16* HM = (bf16*)(a.ws + WS_HM);
    constexpr int C4 = DFF / 4;
    for (int it = gtid; it < 128 * 2 * C4; it += gthreads) {
        const int c = (it % C4) * 4, bi = it / C4, i = bi & 1, blk = bi >> 1;
        const bool start = (blk & 31) == 0;
        const f32x4 z = (f32x4){0.f, 0.f, 0.f, 0.f};
        const f32x4 g0 = *(const f32x4*)(SG + (size_t)(blk * 2 + i) * DFF + c), u0 = *(const f32x4*)(SU + (size_t)(blk * 2 + i) * DFF + c);
        f32x4 p1, p2;
        if (i == 0) { p1 = start ? z : *(const f32x4*)(TG + (size_t)((blk - 1) * 2 + 1) * DFF + c); p2 = start ? z : *(const f32x4*)(TG + (size_t)((blk - 1) * 2) * DFF + c); }
        else { p1 = *(const f32x4*)(SG + (size_t)(blk * 2) * DFF + c); p2 = start ? z : *(const f32x4*)(TG + (size_t)((blk - 1) * 2 + 1) * DFF + c); }
        const f32x4 w0 = *(const f32x4*)(cw + c), w1 = *(const f32x4*)(cw + DFF + c), w2 = *(const f32x4*)(cw + 2 * DFF + c), bb = *(const f32x4*)(cb + c);
        float h[4];
#pragma unroll
        for (int e = 0; e < 4; ++e) { const float av = w0[e] * p2[e] + w1[e] * p1[e] + w2[e] * g0[e] + bb[e]; h[e] = pg8::silu_f(av) * u0[e]; }
        v2u w; w.x = pk2(h[0], h[1]); w.y = pk2(h[2], h[3]);
        *(v2u*)(HM + (size_t)(blk * 64 + i) * DFF + c) = w;
    }
}

__device__ __forceinline__ void final_row(float* row, const float* g, const float* part, size_t pstride, int lane) {
    f32x4* xr = (f32x4*)row + lane; const f32x4* gr = (const f32x4*)g + lane;
    f32x4 v[8]; float s = 0.f;
#pragma unroll
    for (int j = 0; j < 8; ++j) v[j] = xr[64 * j];
    if (part) {
#pragma unroll 1
        for (int p = 0; p < 8; ++p) { const f32x4* pr = (const f32x4*)(part + p * pstride) + lane;
#pragma unroll
            for (int j = 0; j < 8; ++j) v[j] = v[j] + pr[64 * j]; }
    }
#pragma unroll
    for (int j = 0; j < 8; ++j) s += (v[j].x * v[j].x + v[j].y * v[j].y) + (v[j].z * v[j].z + v[j].w * v[j].w);
    const float rs = rsqrtf(wave_sum(s) * (1.0f / 2048.0f) + EPS);
#pragma unroll
    for (int j = 0; j < 8; ++j) { const f32x4 gg = gr[64 * j]; xr[64 * j] = (f32x4){v[j].x * rs * gg.x, v[j].y * rs * gg.y, v[j].z * rs * gg.z, v[j].w * rs * gg.w}; }
}

#define XB_TMO      128
#define XB_XCNT(j)  (256  + 64 * (j))
#define XB_XSUB(j)  (1280 + 64 * (j))
#define XB_XGEN(j)  (2304 + 64 * (j))
#define XB_TOP      3328
#define XB_TOPGEN   3392
#define XCD_BAR_WORDS 3456
#define XB_SPIN_CAP (1u << 18)

__device__ __forceinline__ unsigned xb_ld(unsigned* p)              { return __hip_atomic_load(p, __ATOMIC_RELAXED, __HIP_MEMORY_SCOPE_AGENT); }
__device__ __forceinline__ unsigned xb_add(unsigned* p, unsigned v) { return __hip_atomic_fetch_add(p, v, __ATOMIC_RELAXED, __HIP_MEMORY_SCOPE_AGENT); }
__device__ __forceinline__ unsigned xb_xcc_id() { return (unsigned)__builtin_amdgcn_s_getreg((3 << 11) | 20) & 0xFu; }
#define XB_SPIN(cond, bar) do { unsigned _sp = 0; while (cond) { __builtin_amdgcn_s_sleep(1); \
    if ((++_sp & 255u) == 0u) { if (xb_ld(&(bar)[XB_TMO])) break; if (_sp > XB_SPIN_CAP) { atomicAdd(&(bar)[XB_TMO], 1u); break; } } } } while (0)

struct XcdBarrier {
    unsigned* bar; unsigned x;
    volatile LAS unsigned* st;
};

__device__ __forceinline__ XcdBarrier xcd_barrier_post(unsigned* bar, volatile LAS unsigned* st) {
    XcdBarrier b; b.bar = bar; b.x = xb_xcc_id(); b.st = st;
    if (threadIdx.x == 0) (void)xb_add(&bar[XB_XCNT(b.x)], 1u);
    return b;
}
__device__ __forceinline__ void xcd_barrier_complete(unsigned* bar, unsigned x, unsigned& nloc, unsigned& nx) {
    const unsigned G = gridDim.x * gridDim.y * gridDim.z;
    unsigned sum, cnt, mine, sp = 0u;
    for (;;) {
        sum = 0u; cnt = 0u; mine = 0u;
#pragma unroll
        for (unsigned j = 0; j < 16; ++j) { const unsigned c = xb_ld(&bar[XB_XCNT(j)]); sum += c; cnt += (c > 0u) ? 1u : 0u; mine = (j == x) ? c : mine; }
        if (sum == G) break;
        __builtin_amdgcn_s_sleep(1);
        if ((++sp & 255u) == 0u) { if (xb_ld(&bar[XB_TMO])) break; if (sp > XB_SPIN_CAP) { atomicAdd(&bar[XB_TMO], 1u); break; } }
    }
    nloc = mine > 0u ? mine : 1u; nx = cnt > 0u ? cnt : 1u;
}

__device__ __forceinline__ void xcd_barrier(const XcdBarrier& b) {
    asm volatile("s_waitcnt vmcnt(0)" ::: "memory");
    __syncthreads();
    if (threadIdx.x == 0) {
        unsigned* bar = b.bar;
        __builtin_amdgcn_s_waitcnt(0);
        unsigned nloc = b.st[0], nx = b.st[1];
        if (nloc == 0u) { xcd_barrier_complete(bar, b.x, nloc, nx); b.st[0] = nloc; b.st[1] = nx; }
        const unsigned old = xb_add(&bar[XB_XSUB(b.x)], 1u);
        const unsigned gen = old / nloc;
        if (old + 1u == (gen + 1u) * nloc) {
            __builtin_amdgcn_fence(__ATOMIC_RELEASE, "agent");
            asm volatile("s_waitcnt vmcnt(0)" ::: "memory");
            const unsigned og = xb_add(&bar[XB_TOP], 1u);
            const unsigned tg = og / nx;
            if (og + 1u == (tg + 1u) * nx) xb_add(&bar[XB_TOPGEN], 1u);
            else XB_SPIN(xb_ld(&bar[XB_TOPGEN]) == tg, bar);
            __builtin_amdgcn_fence(__ATOMIC_ACQUIRE, "agent");
            xb_add(&bar[XB_XGEN(b.x)], 1u);
            asm volatile("s_waitcnt vmcnt(0)" ::: "memory");
        } else {
            XB_SPIN(xb_ld(&bar[XB_XGEN(b.x)]) == gen, bar);
            __builtin_amdgcn_fence(__ATOMIC_ACQUIRE, "agent");
            asm volatile("s_waitcnt vmcnt(0)" ::: "memory");
        }
    }
    __syncthreads();
}


#ifndef ONE_LAUNCH
#define ONE_LAUNCH 1
#endif
constexpr int NPHASE = 9;


__global__ void __launch_bounds__(NTHR, 2) hymba_fwd(Args a) {
    extern __shared__ __attribute__((aligned(16))) unsigned char lds_raw[];
    LAS unsigned char* lds = (LAS unsigned char*)lds_raw;
    cg::grid_group grid = cg::this_grid();
    const int tid = threadIdx.x, lane = tid & 63, wave = __builtin_amdgcn_readfirstlane(tid >> 6);
    const int G = gridDim.x, bx = blockIdx.x;
    const int vcu = (G % 8 == 0) ? (bx % 8) * (G / 8) + bx / 8 : bx;
    const int gw = vcu * NWAVES + wave, NGW = G * NWAVES;
    const int lo = a.ph_lo, hi = a.ph_hi;
    unsigned char* ws = a.ws;
#ifndef PHMASK
#define PHMASK 0x1ff
#endif
#define IN(k) (((PHMASK >> (k)) & 1) && lo <= (k) && (k) < hi)
#define SEAM(k) do { if (IN(k) && IN((k) + 1)) xcd_barrier(xbar); } while (0)
    if (tid < 4) ((LAS unsigned*)(lds + LDS_XB_OFF))[tid] = 0u;
    __syncthreads();
    XcdBarrier xbar = xcd_barrier_post((unsigned*)(ws + WS_BAR), (volatile LAS unsigned*)(lds + LDS_XB_OFF));
    if (hi > 1000) grid.sync();

    if (IN(0)) {
        LAS float* scr = (LAS float*)(lds + wave * 16384);
        constexpr int I_IN = (DM / 64) * (NIN / 32), I_OUT = (DM / 64) * (DM / 32), I_G = (DM / 64) * (DFF / 32), I_DN = (DFF / 64) * (DM / 32);
        constexpr int NITEMS = I_IN + I_OUT + 2 * I_G + I_DN;
        for (int it = gw; it < NITEMS; it += NGW) {
            int r = it;
            if (r < I_IN) { p0_transpose_item<0>(a.in[7], DM, NIN, (bf16*)(ws + WS_WIN), nullptr, scr, r, lane); continue; } r -= I_IN;
            if (r < I_OUT) { p0_transpose_item<0>(a.in[12], DM, DM, (bf16*)(ws + WS_WOUT), nullptr, scr, r, lane); continue; } r -= I_OUT;
            if (r < I_G) { p0_transpose_item<1>(a.in[14], DM, DFF, (bf16*)(ws + WS_WGU), a.in[13], scr, r, lane); continue; } r -= I_G;
            if (r < I_G) { p0_transpose_item<2>(a.in[15], DM, DFF, (bf16*)(ws + WS_WGU), a.in[13], scr, r, lane); continue; } r -= I_G;
            p0_transpose_item<0>(a.in[18], DFF, DM, (bf16*)(ws + WS_WDN), nullptr, scr, r, lane);
        }
        for (int m = gw; m < MT; m += NGW) {
            const float* xrow = m < MP ? a.in[0] + (size_t)m * DM : a.in[1] + (size_t)(m - MP) * DM;
            rms_row_to_bf16(xrow, a.in[6], (bf16*)(ws + WS_H) + (size_t)m * DM, lane);
        }
        for (int i = bx * NTHR + tid; i < MT; i += G * NTHR) ((float*)(ws + WS_SS1))[i] = 0.f;
    }
    SEAM(0);
    if (IN(1)) {
        __syncthreads();
        pg8::Gemm g{(const pg8::bf16_t*)(ws + WS_H), (const pg8::bf16_t*)(ws + WS_WIN), MT, NIN, DM}; pg8::StaticOrder S; S.init(MT, NIN, G, bx);
        pg8::EpiBf16<0> E{(pg8::bf16_t*)(ws + WS_QKV), NIN, nullptr, 0, 0, 1.f};
        pg8::gemm_phase<pg8::EpiBf16<0>, pg8::StaticOrder, true, true>(lds, g, S, E);
    }
    SEAM(1);
    if (IN(2)) { __syncthreads(); attn_phase(a, lds, tid, lane, wave); }
    SEAM(2);
    if (IN(3)) { for (int m = gw; m < MT; m += NGW) mix_row(a, m, lane); }
    SEAM(3);
    if (IN(4)) {
        __syncthreads();
        pg8::Gemm g{(const pg8::bf16_t*)(ws + WS_MIX), (const pg8::bf16_t*)(ws + WS_WOUT), MT, DM, DM}; pg8::StaticOrder S; S.init(MT, DM, G, bx);
        pg8::EpiRes E{a.in[0], a.in[1], a.out + O_Y, (pg8::bf16_t*)(ws + WS_H), (float*)(ws + WS_SS1), nullptr};
        pg8::gemm_phase<pg8::EpiRes, pg8::StaticOrder, true, true>(lds, g, S, E);
    }
    SEAM(4);
    if (IN(5)) {
        __syncthreads();
        pg8::Gemm g{(const pg8::bf16_t*)(ws + WS_H), (const pg8::bf16_t*)(ws + WS_WGU), MT, 2 * DFF, DM}; pg8::StaticOrder S; S.init(MT, 2 * DFF, G, bx);
        pg8::EpiGU E{(pg8::bf16_t*)(ws + WS_HM), (const float*)(ws + WS_SS1), a.in[16], a.in[17], a.in[5],
                     (float*)(ws + WS_SG), (float*)(ws + WS_SU), (float*)(ws + WS_TG), a.out + O_FFP, a.out + O_FFS};
        pg8::gemm_phase<pg8::EpiGU, pg8::StaticOrder, true, true>(lds, g, S, E);
    }
    SEAM(5);
    if (IN(6)) fixup_phase(a, bx * NTHR + tid, G * NTHR);
    SEAM(6);
    if (IN(7)) {
        __syncthreads();
        pg8::Gemm g{(const pg8::bf16_t*)(ws + WS_HM), (const pg8::bf16_t*)(ws + WS_WDN), MT, DM, DFF}; pg8::SplitOrder S; S.init(DM, G, bx, 12, 10);
        pg8::EpiRes E{a.out + O_Y, a.out + O_Y + (size_t)MP * DM, a.out + O_Y, nullptr, nullptr, G == 256 ? (float*)(ws + WS_H) : nullptr};
        pg8::gemm_phase<pg8::EpiRes, pg8::SplitOrder, true, true>(lds, g, S, E);
    }
    SEAM(7);
    if (IN(8)) { for (int m = gw; m < MT; m += NGW) final_row(a.out + O_Y + (size_t)m * DM, a.in[19], (G == 256 && m >= MP) ? (const float*)(ws + WS_H) + (size_t)(m - MP) * DM : nullptr, (size_t)1024 * DM, lane); }
#undef IN
#undef SEAM
}

extern "C" void kernel_launch(void* const* d_in, const int* in_sizes, int n_in, void* d_out, int out_size, void* d_ws, size_t ws_size, hipStream_t stream) {
    static int grid = 0;
    if (grid == 0) {
        if (n_in != 20 || out_size != (int)O_END || ws_size < WS_END) { fprintf(stderr, "kernel_launch: unexpected shapes (n_in %d, out %d, ws %zu)\n", n_in, out_size, ws_size); grid = -1; return; }
        int dev = 0, cus = 0, per_cu = 0;
        (void)hipGetDevice(&dev); (void)hipDeviceGetAttribute(&cus, hipDeviceAttributeMultiprocessorCount, dev);
        if (hipFuncSetAttribute((const void*)hymba_fwd, hipFuncAttributeMaxDynamicSharedMemorySize, LDS_BYTES) != hipSuccess) { fprintf(stderr, "kernel_launch: hipFuncSetAttribute failed\n"); grid = -1; return; }
        if (hipOccupancyMaxActiveBlocksPerMultiprocessor(&per_cu, (const void*)hymba_fwd, NTHR, LDS_BYTES) != hipSuccess || per_cu < 1) { fprintf(stderr, "kernel_launch: occupancy query says %d\n", per_cu); per_cu = 1; }
        (void)hipGetLastError();
        grid = cus * per_cu;
        fprintf(stderr, "kernel_launch: grid %d (cus %d x %d)\n", grid, cus, per_cu);
    }
    if (grid < 0) return;
    (void)hipMemsetAsync(d_ws, 0, CTL_ZERO_BYTES, stream);
    Args a{};
    for (int i = 0; i < 20; ++i) a.in[i] = (const float*)d_in[i];
    a.out = (float*)d_out; a.ws = (unsigned char*)d_ws;
#if ONE_LAUNCH
    a.ph_lo = 0; a.ph_hi = NPHASE;
    void* args[] = {&a};
    hipError_t e = hipLaunchCooperativeKernel((const void*)hymba_fwd, dim3(grid), dim3(NTHR), args, LDS_BYTES, stream);
    if (e != hipSuccess) fprintf(stderr, "kernel_launch: cooperative launch failed: %s (grid %d)\n", hipGetErrorString(e), grid);
#else
    for (int p = 0; p < NPHASE; ++p) {
        a.ph_lo = p; a.ph_hi = p + 1;
        hipLaunchKernelGGL(hymba_fwd, dim3(grid), dim3(NTHR), LDS_BYTES, stream, a);
    }
#endif
}
```

```cpp
#include <hip/hip_runtime.h>
#include <hip/hip_cooperative_groups.h>
#include <cstdio>
#include <cstdint>
namespace cg = cooperative_groups;
namespace pg8 {
#define PG8_LAS __attribute__((address_space(3)))
typedef unsigned short bf16_t;
typedef short bf16x8 __attribute__((ext_vector_type(8)));
typedef float f32x4 __attribute__((ext_vector_type(4)));
typedef unsigned u32x4 __attribute__((ext_vector_type(4)));
constexpr int BM = 256, BK = 64, HALF = 128, HTB = HALF * BK * 2  , STAGE_BYTES = 8 * HTB, NXCD = 8, WGM = 8;

__host__ __device__ __forceinline__ int lds_byte(int r, int c) { const int st = (r >> 4) * 2 + (c >> 5), rr = r & 15, cc = c & 31, ob = rr * 64 + cc * 2; return st * 1024 + (ob ^ (((ob >> 9) & 1) << 5)); }
__host__ __device__ __forceinline__ void stage_rc(int b, int& R, int& C) { const int st = b / 1024, sb = b % 1024, swz = sb ^ (((sb >> 9) & 1) << 5); R = (st >> 1) * 16 + swz / 64; C = (st & 1) * 32 + (swz % 64) / 2; }
__host__ __device__ __forceinline__ int perm32(int rho) { const int n = rho >> 4, i = rho & 15; return 8 * (i >> 2) + 4 * n + (i & 3); }

struct Unit { int pm, pn, kt0, nkt, split; };
struct Gemm { const bf16_t* A; const bf16_t* Bt; int M, N, K; };

struct StaticOrder {
    int nM, nN, nwg, G, c;
    __host__ __device__ void init(int M, int N, int G_, int c_) { nM = M / BM; nN = N / BM; nwg = nM * nN; G = G_; c = c_; }
    __host__ __device__ bool next(int i, Unit& u) const {
        const long L = (long)i * G + c; if (L >= nwg) return false;
        int wgid = (int)L; { const int q = nwg / NXCD, r = nwg % NXCD, xcd = wgid % NXCD, off = wgid / NXCD; wgid = (xcd < r ? xcd * (q + 1) : r * (q + 1) + (xcd - r) * q) + off; }
        const int nig = WGM * nN, gid = wgid / nig, fm = gid * WGM, gsz = (nM - fm) < WGM ? (nM - fm) : WGM;
        u.pm = fm + ((wgid % nig) % gsz); u.pn = (wgid % nig) / gsz; u.kt0 = 0; u.nkt = 0; u.split = 0; return true;
    }
    __device__ __forceinline__ void a_ready(const Unit&) const {}
    __device__ __forceinline__ void done(const Unit&) const {}
};

__device__ __forceinline__ unsigned cvt_pk_bf16(float lo, float hi) { unsigned r; asm volatile("v_cvt_pk_bf16_f32 %0, %1, %2" : "=v"(r) : "v"(lo), "v"(hi)); return r; }
typedef float f32x2 __attribute__((ext_vector_type(2)));
__device__ __forceinline__ f32x2 gelu_pk(f32x2 v) {
    const f32x2 av = __builtin_elementwise_abs(v), d = av * 0.2316418882f + 1.0f;
    f32x2 t; t.x = __builtin_amdgcn_rcpf(d.x); t.y = __builtin_amdgcn_rcpf(d.y);
    f32x2 q = t * 0.5307027145f + (-0.7265760135f); q = q * t + 0.7107068705f; q = q * t + (-0.142248368f); q = q * t + 0.127414796f; q = q * t;
    const f32x2 s = (v * v) * (-0.72134752044f);
    f32x2 e; e.x = __builtin_amdgcn_exp2f(s.x); e.y = __builtin_amdgcn_exp2f(s.y);
    const f32x2 m = v * (q * e), r = v - m;
    f32x2 o; o.x = v.x < 0.f ? m.x : r.x; o.y = v.y < 0.f ? m.y : r.y; return o;
}

template <int ACT  > struct EpiBf16 {
    static constexpr bool PERM = true, AFTER_DRAIN = false; static_assert(ACT == 0 || ACT == 1, "EpiBf16: ACT is 0 (none) or 1 (gelu_pk)");
    bf16_t* O; int ldc; const float* bias; int split_cols; size_t split_stride; float scale0;
    __device__ __forceinline__ void operator()(const f32x4 (&acc)[2][2][4][2], const Unit& u, int wr, int wc, int fr, int fq) const {
        const int row0 = u.pm * BM + wr * 64 + fr; int colt = u.pn * BM; bf16_t* base = O;
        float sc = 1.f; if (split_cols) { const int t = colt / split_cols; base += (size_t)t * split_stride; colt -= t * split_cols; if (t == 0) sc = scale0; }
        const int col0 = colt + wc * 32 + 8 * fq, bcol0 = u.pn * BM + wc * 32 + 8 * fq;
        f32x4 bv[2][2];
#pragma unroll
        for (int bj = 0; bj < 2; ++bj)
#pragma unroll
            for (int n = 0; n < 2; ++n) bv[bj][n] = bias ? *(const f32x4*)(bias + bcol0 + bj * HALF + 4 * n) : (f32x4){0.f, 0.f, 0.f, 0.f};
#pragma unroll
        for (int ai = 0; ai < 2; ++ai)
#pragma unroll
            for (int m = 0; m < 4; ++m) { bf16_t* rowp = base + (size_t)(row0 + ai * HALF + m * 16) * ldc + col0;
#pragma unroll
                for (int bj = 0; bj < 2; ++bj) { f32x4 v0 = acc[ai][bj][m][0] + bv[bj][0], v1 = acc[ai][bj][m][1] + bv[bj][1];
                    if (ACT == 1) { f32x2 a = gelu_pk((f32x2){v0[0], v0[1]}), b = gelu_pk((f32x2){v0[2], v0[3]}), c = gelu_pk((f32x2){v1[0], v1[1]}), d = gelu_pk((f32x2){v1[2], v1[3]});
                        v0 = (f32x4){a.x, a.y, b.x, b.y}; v1 = (f32x4){c.x, c.y, d.x, d.y}; }
                    v0 = v0 * sc; v1 = v1 * sc; u32x4 w; w.x = cvt_pk_bf16(v0[0], v0[1]); w.y = cvt_pk_bf16(v0[2], v0[3]); w.z = cvt_pk_bf16(v1[0], v1[1]); w.w = cvt_pk_bf16(v1[2], v1[3]);
                    *(u32x4*)(rowp + bj * HALF) = w; } }
    }
};
template <class Epi, class Sched, bool ALIGN_EPI = false, bool SP2 = false>
__device__ __forceinline__ void gemm_phase(PG8_LAS unsigned char* lds, const Gemm g, const Sched& S, const Epi& E) {
    const int tid = threadIdx.x, wid = __builtin_amdgcn_readfirstlane(tid >> 6), lane = tid & 63, wr = wid >> 2, wc = wid & 3, fr = lane & 15, fq = lane >> 4;
    const int K = g.K;
    unsigned voffA[2], voffB[2];
#pragma unroll
    for (int i = 0; i < 2; ++i) { int R, C; stage_rc(tid * 16 + i * 8192, R, C); const int Rb = Epi::PERM ? ((R & ~31) + perm32(R & 31)) : R;
        voffA[i] = (unsigned)(R * K + C) * 2u; voffB[i] = (unsigned)(Rb * K + C) * 2u; }
    const size_t kstep = (size_t)(BK * 2);
    const size_t hstep = (size_t)HALF * K * 2;
    const size_t tstep = 2 * hstep;
    const unsigned ldsw = (unsigned)wid * 1024u;
    const int aoff = lds_byte(wr * 64 + fr, fq * 8), boff = lds_byte(wc * 32 + fr, fq * 8);
#define PG8_SA(b, h) (((b) * 2 + (h)) * HTB)
#define PG8_SB(b, h) ((4 + (b) * 2 + (h)) * HTB)
#define PG8_STAGE(bufoff, gbase, voff) do { _Pragma("unroll") for (int _i = 0; _i < 2; ++_i) \
        __builtin_amdgcn_global_load_lds((const unsigned*)((const char*)(gbase) + (voff)[_i]), (PG8_LAS unsigned*)(lds + (bufoff) + ldsw + _i * 8192), 16, 0, 0); } while (0)
#define PG8_LDA(dst, b, h) do { _Pragma("unroll") for (int m = 0; m < 4; ++m) _Pragma("unroll") for (int k = 0; k < 2; ++k) dst[m][k] = *(const PG8_LAS bf16x8*)(lds + PG8_SA(b, h) + aoff + m * 2048 + k * 1024); } while (0)
#define PG8_LDB(dst, b, h) do { _Pragma("unroll") for (int n = 0; n < 2; ++n) _Pragma("unroll") for (int k = 0; k < 2; ++k) dst[n][k] = *(const PG8_LAS bf16x8*)(lds + PG8_SB(b, h) + boff + n * 2048 + k * 1024); } while (0)
#define PG8_MMA(ai, bj, At, Bt) do { __builtin_amdgcn_s_setprio(1); _Pragma("unroll") for (int m = 0; m < 4; ++m) _Pragma("unroll") for (int n = 0; n < 2; ++n) _Pragma("unroll") for (int k = 0; k < 2; ++k) \
        acc[ai][bj][m][n] = __builtin_amdgcn_mfma_f32_16x16x32_bf16(Bt[n][k], At[m][k], acc[ai][bj][m][n], 0, 0, 0); __builtin_amdgcn_s_setprio(0); } while (0)
#define PG8_WAIT_V(n) asm volatile("s_waitcnt vmcnt(" #n ")" ::: "memory")
#define PG8_WAIT_L(n) asm volatile("s_waitcnt lgkmcnt(" #n ")" ::: "memory")
#define PG8_BAR __builtin_amdgcn_s_barrier()
#define PG8_SCHED __builtin_amdgcn_sched_barrier(0)
    Unit cur, nxt; int ui = 0;
    if (!S.next(0, cur)) return;
    if (cur.nkt == 0) { cur.kt0 = 0; cur.nkt = K / BK; }
    f32x4 acc[2][2][4][2];
#pragma unroll
    for (int a = 0; a < 2; ++a)
#pragma unroll
        for (int b = 0; b < 2; ++b)
#pragma unroll
            for (int m = 0; m < 4; ++m)
#pragma unroll
                for (int n = 0; n < 2; ++n) acc[a][b][m][n] = (f32x4){0.f, 0.f, 0.f, 0.f};
    bf16x8 At[4][2], B0[2][2], B1[2][2];
    const char* cA = (const char*)g.A + (size_t)cur.pm * tstep + (size_t)cur.kt0 * kstep; const char* cB = (const char*)g.Bt + (size_t)cur.pn * tstep + (size_t)cur.kt0 * kstep;
    S.a_ready(cur);
    if constexpr (SP2) {
        PG8_STAGE(PG8_SB(0, 0), cB, voffB); PG8_STAGE(PG8_SB(0, 1), cB + hstep, voffB); PG8_STAGE(PG8_SA(0, 0), cA, voffA); PG8_STAGE(PG8_SA(0, 1), cA + hstep, voffA);
        if (wr == 1) PG8_BAR;
        PG8_WAIT_V(2); PG8_BAR;
        PG8_STAGE(PG8_SB(1, 0), cB + kstep, voffB); PG8_STAGE(PG8_SA(1, 0), cA + kstep, voffA); PG8_STAGE(PG8_SB(1, 1), cB + hstep + kstep, voffB);
        PG8_WAIT_V(6); PG8_BAR;
    } else {
        PG8_STAGE(PG8_SB(0, 0), cB, voffB); PG8_STAGE(PG8_SA(0, 0), cA, voffA); PG8_STAGE(PG8_SB(0, 1), cB + hstep, voffB); PG8_STAGE(PG8_SA(0, 1), cA + hstep, voffA);
        if (wr == 1) PG8_BAR;
        PG8_WAIT_V(4); PG8_BAR;
        PG8_STAGE(PG8_SB(1, 0), cB + kstep, voffB); PG8_STAGE(PG8_SA(1, 0), cA + kstep, voffA); PG8_STAGE(PG8_SB(1, 1), cB + hstep + kstep, voffB);
        PG8_WAIT_V(6); PG8_BAR;
    }
    for (;;) {
        const bool has_next = S.next(ui + 1, nxt);
        if (has_next && nxt.nkt == 0) { nxt.kt0 = 0; nxt.nkt = K / BK; }
        const int nt = cur.nkt;
        const char* nA = has_next ? (const char*)g.A + (size_t)nxt.pm * tstep + (size_t)nxt.kt0 * kstep : cA; const char* nB = has_next ? (const char*)g.Bt + (size_t)nxt.pn * tstep + (size_t)nxt.kt0 * kstep : cB;
        for (int t = 0; t < nt; t += 2) {
            const bool last = (t == nt - 2);
            const char* a1 = cA + (size_t)(t + 1) * kstep;
            const char* a2 = last ? nA : cA + (size_t)(t + 2) * kstep; const char* b2 = last ? nB : cB + (size_t)(t + 2) * kstep;
            const char* a3 = a2 + kstep; const char* b3 = b2 + kstep;
            if (last && has_next) S.a_ready(nxt);
            if constexpr (SP2) {
            PG8_LDB(B0, 0, 0); PG8_LDB(B1, 0, 1); PG8_SCHED; PG8_LDA(At, 0, 0); PG8_STAGE(PG8_SA(1, 1), a1 + hstep, voffA);
            PG8_WAIT_V(8); PG8_WAIT_L(0); PG8_BAR; PG8_MMA(0, 0, At, B0); PG8_MMA(0, 1, At, B1); PG8_BAR; PG8_SCHED;
            PG8_LDA(At, 0, 1); PG8_STAGE(PG8_SB(0, 0), b2, voffB); PG8_STAGE(PG8_SB(0, 1), b2 + hstep, voffB); PG8_STAGE(PG8_SA(0, 0), a2, voffA);
            PG8_WAIT_V(8); PG8_WAIT_L(0); PG8_BAR; PG8_MMA(1, 0, At, B0); PG8_MMA(1, 1, At, B1); PG8_BAR; PG8_SCHED;
            PG8_LDB(B0, 1, 0); PG8_LDB(B1, 1, 1); PG8_SCHED; PG8_LDA(At, 1, 0); PG8_STAGE(PG8_SA(0, 1), a2 + hstep, voffA);
            PG8_WAIT_V(8); PG8_WAIT_L(0); PG8_BAR; PG8_MMA(0, 0, At, B0); PG8_MMA(0, 1, At, B1); PG8_BAR; PG8_SCHED;
            PG8_LDA(At, 1, 1); PG8_STAGE(PG8_SB(1, 0), b3, voffB); PG8_STAGE(PG8_SB(1, 1), b3 + hstep, voffB); PG8_STAGE(PG8_SA(1, 0), a3, voffA);
            PG8_WAIT_V(8); PG8_WAIT_L(0); PG8_BAR; PG8_MMA(1, 0, At, B0); PG8_MMA(1, 1, At, B1); PG8_BAR; PG8_SCHED;
            } else {
            PG8_LDB(B0, 0, 0); PG8_SCHED; PG8_LDA(At, 0, 0); PG8_STAGE(PG8_SA(1, 1), a1 + hstep, voffA);
            PG8_WAIT_L(8); PG8_BAR; PG8_WAIT_L(0); PG8_MMA(0, 0, At, B0); PG8_BAR; PG8_SCHED;
            PG8_LDB(B1, 0, 1); PG8_STAGE(PG8_SB(0, 0), b2, voffB);
            PG8_BAR; PG8_WAIT_L(0); PG8_MMA(0, 1, At, B1); PG8_BAR;
            PG8_LDA(At, 0, 1); PG8_STAGE(PG8_SA(0, 0), a2, voffA);
            PG8_BAR; PG8_WAIT_L(0); PG8_MMA(1, 0, At, B0); PG8_BAR; PG8_SCHED;
            PG8_STAGE(PG8_SB(0, 1), b2 + hstep, voffB);
            PG8_WAIT_V(6); PG8_BAR; PG8_MMA(1, 1, At, B1); PG8_BAR;
            PG8_LDB(B0, 1, 0); PG8_SCHED; PG8_LDA(At, 1, 0); PG8_STAGE(PG8_SA(0, 1), a2 + hstep, voffA);
            PG8_WAIT_L(8); PG8_BAR; PG8_WAIT_L(0); PG8_MMA(0, 0, At, B0); PG8_BAR; PG8_SCHED;
            PG8_LDB(B1, 1, 1); PG8_STAGE(PG8_SB(1, 0), b3, voffB);
            PG8_BAR; PG8_WAIT_L(0); PG8_MMA(0, 1, At, B1); PG8_BAR;
            PG8_LDA(At, 1, 1); PG8_STAGE(PG8_SA(1, 0), a3, voffA);
            PG8_BAR; PG8_WAIT_L(0); PG8_MMA(1, 0, At, B0); PG8_BAR; PG8_SCHED;
            PG8_STAGE(PG8_SB(1, 1), b3 + hstep, voffB);
            PG8_WAIT_V(6); PG8_BAR; PG8_MMA(1, 1, At, B1); PG8_BAR;
            }
        }
        if constexpr (ALIGN_EPI) { if (wr == 0) PG8_BAR; }
        if constexpr (!Epi::AFTER_DRAIN) { E(acc, cur, wr, wc, fr, fq); S.done(cur); }
        if (!has_next) break;
#pragma unroll
        for (int a = 0; a < 2; ++a)
#pragma unroll
            for (int b = 0; b < 2; ++b)
#pragma unroll
                for (int m = 0; m < 4; ++m)
#pragma unroll
                    for (int n = 0; n < 2; ++n) acc[a][b][m][n] = (f32x4){0.f, 0.f, 0.f, 0.f};
        cur = nxt; cA = nA; cB = nB; ++ui;
        if constexpr (ALIGN_EPI) { if (wr == 1) PG8_BAR; }
    }
    PG8_WAIT_V(0);
    if constexpr (!ALIGN_EPI) { if (wr == 0) PG8_BAR; }
    PG8_BAR;
    if constexpr (Epi::AFTER_DRAIN) { E.fused(acc, cur, wr, wc, fr, fq, lds, wid, lane); S.done(cur); }
#undef PG8_SA
#undef PG8_SB
#undef PG8_STAGE
#undef PG8_LDA
#undef PG8_LDB
#undef PG8_MMA
#undef PG8_WAIT_V
#undef PG8_WAIT_L
#undef PG8_BAR
#undef PG8_SCHED
}
}

namespace pg8 {
struct EpiRes {
    static constexpr bool PERM = true, AFTER_DRAIN = false;
    const float* xp; const float* xs; float* out; bf16_t* xb; float* ss; float* part;
    __device__ __forceinline__ void operator()(const f32x4 (&acc)[2][2][4][2], const Unit& u, int wr, int wc, int fr, int fq) const {
        if (u.split) {
#pragma unroll
            for (int ai = 0; ai < 2; ++ai)
#pragma unroll
                for (int m = 0; m < 4; ++m) {
                    const int row = u.pm * BM + ai * HALF + wr * 64 + m * 16 + fr;
#pragma unroll
                    for (int bj = 0; bj < 2; ++bj) {
                        const int col = u.pn * BM + bj * HALF + wc * 32 + 8 * fq;
                        float* o = part + ((size_t)(u.split - 1) * 1024 + (row - 8192)) * 2048 + col;
                        *(f32x4*)o = acc[ai][bj][m][0]; *(f32x4*)(o + 4) = acc[ai][bj][m][1];
                    }
                }
            return;
        }
#pragma unroll
        for (int ai = 0; ai < 2; ++ai)
#pragma unroll
            for (int m = 0; m < 4; ++m) {
                const int row = u.pm * BM + ai * HALF + wr * 64 + m * 16 + fr;
                const float* src = row < 8192 ? xp + (size_t)row * 2048 : xs + (size_t)(row - 8192) * 2048;
                float s = 0.f;
#pragma unroll
                for (int bj = 0; bj < 2; ++bj) {
                    const int col = u.pn * BM + bj * HALF + wc * 32 + 8 * fq;
                    const f32x4 a0 = *(const f32x4*)(src + col), a1 = *(const f32x4*)(src + col + 4);
                    const f32x4 v0 = acc[ai][bj][m][0] + a0, v1 = acc[ai][bj][m][1] + a1;
                    *(f32x4*)(out + (size_t)row * 2048 + col) = v0; *(f32x4*)(out + (size_t)row * 2048 + col + 4) = v1;
                    if (xb) { u32x4 w; w.x = cvt_pk_bf16(v0[0], v0[1]); w.y = cvt_pk_bf16(v0[2], v0[3]); w.z = cvt_pk_bf16(v1[0], v1[1]); w.w = cvt_pk_bf16(v1[2], v1[3]);
                        *(u32x4*)(xb + (size_t)row * 2048 + col) = w; }
                    s += (v0[0] * v0[0] + v0[1] * v0[1]) + (v0[2] * v0[2] + v0[3] * v0[3]) + (v1[0] * v1[0] + v1[1] * v1[1]) + (v1[2] * v1[2] + v1[3] * v1[3]);
                }
                if (ss) { s += __shfl_xor(s, 16); s += __shfl_xor(s, 32); if (fq == 0) unsafeAtomicAdd(ss + row, s); }
            }
    }
};

struct SplitOrder {
    StaticOrder full; int G, c, a, b; bool on;
    __host__ __device__ void init(int N, int G_, int c_, int a_, int b_) { G = G_; c = c_; a = a_; b = b_; on = (G_ == 256); full.init(on ? 8192 : 9216, N, G_, c_); }
    __host__ __device__ bool next(int i, Unit& u) const {
        if (!on || i == 0) return full.next(i, u);
        if (i > 1) return false;
        const int su = c >> 3, p = c & 7;
        u.pm = 32 + (su >> 3); u.pn = su & 7; u.kt0 = p < 4 ? a * p : 4 * a + b * (p - 4); u.nkt = p < 4 ? a : b; u.split = 1 + p; return true;
    }
    __device__ __forceinline__ void a_ready(const Unit&) const {}
    __device__ __forceinline__ void done(const Unit&) const {}
};

template <int CTRL> __device__ __forceinline__ float dpp_f(float x) { return __builtin_bit_cast(float, __builtin_amdgcn_update_dpp(0, __builtin_bit_cast(int, x), CTRL, 0xf, 0xf, true)); }
__device__ __forceinline__ float silu_f(float a) { return a * __builtin_amdgcn_rcpf(1.0f + __expf(-a)); }

struct EpiGU {
    static constexpr bool PERM = true, AFTER_DRAIN = false;
    bf16_t* HM; const float* ss1; const float* cw; const float* cb; const float* st;
    float* SG; float* SU; float* TG; float* ffp; float* ffs;
    __device__ __forceinline__ void operator()(const f32x4 (&acc)[2][2][4][2], const Unit& u, int wr, int wc, int fr, int fq) const {
        const int lane = fq * 16 + fr;
        const int col = u.pn * 128 + wc * 32 + 8 * fq;
        float w0[8], w1[8], w2[8], bb[8];
#pragma unroll
        for (int e = 0; e < 8; ++e) { w0[e] = cw[col + e]; w1[e] = cw[5632 + col + e]; w2[e] = cw[2 * 5632 + col + e]; bb[e] = cb[col + e]; }
        const bool samp = u.pm >= 32;
#pragma unroll
        for (int ai = 0; ai < 2; ++ai) {
            const int rb = u.pm * BM + ai * HALF + wr * 64, blk = rb >> 6;
            float r1p[8], r2p[8];
#pragma unroll
            for (int e = 0; e < 8; ++e) { r1p[e] = 0.f; r2p[e] = 0.f; }
#pragma unroll
            for (int m = 0; m < 4; ++m) {
                const int row = rb + 16 * m + fr;
                const float rs = rsqrtf(ss1[row] * (1.0f / 2048.0f) + 1e-6f);
                float g[8], up[8], r1[8], r2[8], p1[8], p2[8];
#pragma unroll
                for (int n = 0; n < 2; ++n)
#pragma unroll
                    for (int j = 0; j < 4; ++j) { g[4 * n + j] = acc[ai][0][m][n][j] * rs; up[4 * n + j] = acc[ai][1][m][n][j] * rs; }
#pragma unroll
                for (int e = 0; e < 8; ++e) { r1[e] = dpp_f<0x111>(g[e]); r2[e] = dpp_f<0x112>(g[e]); }
                bool do_store = true;
                if (!samp) {
#pragma unroll
                    for (int e = 0; e < 8; ++e) { p1[e] = r1[e] + r1p[e]; p2[e] = r2[e] + r2p[e]; }
                    if (m == 0 && fr < 2) {
                        float* sg = SG + (size_t)(blk * 2 + fr) * 5632 + col; float* su = SU + (size_t)(blk * 2 + fr) * 5632 + col;
                        *(f32x4*)sg = (f32x4){g[0], g[1], g[2], g[3]}; *(f32x4*)(sg + 4) = (f32x4){g[4], g[5], g[6], g[7]};
                        *(f32x4*)su = (f32x4){up[0], up[1], up[2], up[3]}; *(f32x4*)(su + 4) = (f32x4){up[4], up[5], up[6], up[7]};
                        do_store = false;
                    }
                    if (m == 3 && fr >= 14) {
                        float* tg = TG + (size_t)(blk * 2 + fr - 14) * 5632 + col;
                        *(f32x4*)tg = (f32x4){g[0], g[1], g[2], g[3]}; *(f32x4*)(tg + 4) = (f32x4){g[4], g[5], g[6], g[7]};
                        if ((blk & 31) == 31) { float* fo = ffp + (size_t)((blk >> 5) * 2 + fr - 14) * 5632 + col;
                            *(f32x4*)fo = (f32x4){g[0], g[1], g[2], g[3]}; *(f32x4*)(fo + 4) = (f32x4){g[4], g[5], g[6], g[7]}; }
                    }
                } else {
                    const int t = fr & 7, b = (row - 8192) >> 3;
                    float s0[8], s1[8];
#pragma unroll
                    for (int e = 0; e < 8; ++e) { s0[e] = 0.f; s1[e] = 0.f; }
                    if (t < 2) {
                        const float* sp = st + (size_t)(b * 2) * 5632 + col;
#pragma unroll
                        for (int e = 0; e < 8; ++e) { s0[e] = sp[e]; s1[e] = sp[5632 + e]; }
                    }
#pragma unroll
                    for (int e = 0; e < 8; ++e) { p1[e] = t >= 1 ? r1[e] : s1[e]; p2[e] = t >= 2 ? r2[e] : (t == 1 ? s1[e] : s0[e]); }
                    if (t >= 6) { float* fo = ffs + (size_t)(b * 2 + t - 6) * 5632 + col;
                        *(f32x4*)fo = (f32x4){g[0], g[1], g[2], g[3]}; *(f32x4*)(fo + 4) = (f32x4){g[4], g[5], g[6], g[7]}; }
                }
                if (do_store) {
                    float h[8];
#pragma unroll
                    for (int e = 0; e < 8; ++e) { const float a = w0[e] * p2[e] + w1[e] * p1[e] + w2[e] * g[e] + bb[e]; h[e] = silu_f(a) * up[e]; }
                    u32x4 w; w.x = cvt_pk_bf16(h[0], h[1]); w.y = cvt_pk_bf16(h[2], h[3]); w.z = cvt_pk_bf16(h[4], h[5]); w.w = cvt_pk_bf16(h[6], h[7]);
                    *(u32x4*)(HM + (size_t)row * 5632 + col) = w;
                }
#pragma unroll
                for (int e = 0; e < 8; ++e) { r1p[e] = dpp_f<0x10F>(g[e]); r2p[e] = dpp_f<0x10E>(g[e]); }
            }
        }
    }
};
}

#define LAS __attribute__((address_space(3)))
typedef unsigned short bf16;
typedef unsigned v4u __attribute__((ext_vector_type(4)));
typedef unsigned v2u __attribute__((ext_vector_type(2)));
typedef float f32x4 __attribute__((ext_vector_type(4)));
typedef short bf16x8 __attribute__((ext_vector_type(8)));

constexpr int DM = 2048, MP = 8192, MS = 1024, MT = 9216, SEQ = 2048, NIN = 4608, DFF = 5632;
constexpr int QK_OFF = 1024, QV_OFF = 1280, QB_OFF = 1536, QC_OFF = 2560, QU_OFF = 3584;
constexpr int NWAVES = 8, NTHR = 512;
constexpr int LDS_BYTES = 147456;
constexpr float EPS = 1e-6f;

constexpr size_t O_Y = 0, O_KWP = 18874368, O_VWP = 19005440, O_CVP = 19136512, O_FFP = 19144704,
                 O_KWS = 19189760, O_VWS = 23384064, O_CVS = 27578368, O_FFS = 27840512, O_END = 29282304;
constexpr size_t MiB = 1u << 20;
constexpr size_t WS_SS1 = 0;
constexpr size_t WS_BAR = 65536, CTL_ZERO_BYTES = 131072;
constexpr int LDS_XB_OFF = 131072 + 64;
constexpr size_t WS_WIN = 1 * MiB;
constexpr size_t WS_WOUT = 19 * MiB;
constexpr size_t WS_WGU = 27 * MiB;
constexpr size_t WS_WDN = 71 * MiB;
constexpr size_t WS_H = 93 * MiB;
constexpr size_t WS_MIX = 129 * MiB;
constexpr size_t WS_QKV = 165 * MiB;
constexpr size_t WS_ATT = 246 * MiB;
constexpr size_t WS_HM = 165 * MiB;
constexpr size_t WS_SG = 264 * MiB, WS_SU = 271 * MiB, WS_TG = 278 * MiB, WS_END = 285 * MiB;

struct Args { const float* in[20]; float* out; unsigned char* ws; int ph_lo, ph_hi; };

__device__ __forceinline__ unsigned f2bf(float f) { unsigned u = __builtin_bit_cast(unsigned, f); return (u + 0x7fffu + ((u >> 16) & 1u)) >> 16; }
__device__ __forceinline__ unsigned pk2(float lo, float hi) { return pg8::cvt_pk_bf16(lo, hi); }
__device__ __forceinline__ float bflo(unsigned w) { return __builtin_bit_cast(float, w << 16); }
__device__ __forceinline__ float bfhi(unsigned w) { return __builtin_bit_cast(float, w & 0xffff0000u); }
__device__ __forceinline__ float wave_sum(float v) {
#pragma unroll
    for (int o = 1; o < 64; o <<= 1) v += __shfl_xor(v, o);
    return v;
}
#define LDS_WAIT() asm volatile("s_waitcnt lgkmcnt(0)" ::: "memory")

template <int MODE>
__device__ __forceinline__ void p0_transpose_item(const float* W, int K, int N, bf16* WT, const float* kscale, LAS float* scr, int item, int lane) {
    const int nblk = N / 32, kb = item / nblk, nb = item % nblk, k0 = 64 * kb, n0 = 32 * nb;
    f32x4 v[8];
#pragma unroll
    for (int i = 0; i < 8; ++i) v[i] = *(const f32x4*)(W + (size_t)(k0 + 8 * i + (lane >> 3)) * N + n0 + 4 * (lane & 7));
#pragma unroll
    for (int i = 0; i < 8; ++i) { const int kk = 8 * i + (lane >> 3); f32x4 x = v[i]; if (kscale) x = x * kscale[k0 + kk];
        LAS float* d = scr + kk * 33 + 4 * (lane & 7); d[0] = x.x; d[1] = x.y; d[2] = x.z; d[3] = x.w; }
    LDS_WAIT(); asm volatile("" ::: "memory");
    const int c = lane & 7;
#pragma unroll
    for (int j = 0; j < 4; ++j) { const int n = (lane >> 3) + 8 * j; const LAS float* s = scr + (8 * c) * 33 + n;
        v4u o; o.x = pk2(s[0 * 33], s[1 * 33]); o.y = pk2(s[2 * 33], s[3 * 33]); o.z = pk2(s[4 * 33], s[5 * 33]); o.w = pk2(s[6 * 33], s[7 * 33]);
        const int nn = n0 + n; const int drow = MODE == 0 ? nn : ((nn >> 7) * 256 + (MODE - 1) * 128 + (nn & 127));
        *(v4u*)(WT + (size_t)drow * K + k0 + 8 * c) = o; }
    LDS_WAIT(); asm volatile("" ::: "memory");
}

__device__ __forceinline__ void rms_row_to_bf16(const float* xrow, const float* g, bf16* orow, int lane) {
    const f32x4* xr = (const f32x4*)xrow + lane; const f32x4* gr = (const f32x4*)g + lane;
    f32x4 v[8]; float s = 0.f;
#pragma unroll
    for (int j = 0; j < 8; ++j) { v[j] = xr[64 * j]; s += (v[j].x * v[j].x + v[j].y * v[j].y) + (v[j].z * v[j].z + v[j].w * v[j].w); }
    const float rs = rsqrtf(wave_sum(s) * (1.0f / 2048.0f) + EPS);
    v2u* o8 = (v2u*)orow + lane;
#pragma unroll
    for (int j = 0; j < 8; ++j) { const f32x4 gg = gr[64 * j]; v2u o; o.x = pk2(v[j].x * rs * gg.x, v[j].y * rs * gg.y); o.y = pk2(v[j].z * rs * gg.z, v[j].w * rs * gg.w); o8[64 * j] = o; }
}

constexpr int VI_OUT = (DM / 64) * (DM / 32), VI_G = (DM / 64) * (DFF / 32), VI_DN = (DFF / 64) * (DM / 32), VI_END = VI_OUT + 2 * VI_G + VI_DN;
constexpr int VI_CUT1 = 4048, VI_CUT2 = VI_OUT + 2 * VI_G;
__device__ __forceinline__ void convert_range(const Args& a, LAS float* scr, int lo, int hi, int first, int stride, int lane) {
    unsigned char* ws = a.ws;
#pragma unroll 1
    for (int it = lo + first; it < hi; it += stride) {
        int r = it;
        if (r < VI_OUT) { p0_transpose_item<0>(a.in[12], DM, DM, (bf16*)(ws + WS_WOUT), nullptr, scr, r, lane); continue; } r -= VI_OUT;
        if (r < VI_G) { p0_transpose_item<1>(a.in[14], DM, DFF, (bf16*)(ws + WS_WGU), a.in[13], scr, r, lane); continue; } r -= VI_G;
        if (r < VI_G) { p0_transpose_item<2>(a.in[15], DM, DFF, (bf16*)(ws + WS_WGU), a.in[13], scr, r, lane); continue; } r -= VI_G;
        p0_transpose_item<0>(a.in[18], DFF, DM, (bf16*)(ws + WS_WDN), nullptr, scr, r, lane);
    }
}
#define IDLE_CONVERT(nwg, lo_, hi_) do { const int rem_ = (nwg) % G; if (bx >= rem_) convert_range(a, (LAS float*)(lds + wave * 16384), (lo_), (hi_), (bx - rem_) * NWAVES + wave, (G - rem_) * NWAVES, lane); } while (0)

constexpr int KS_PITCH = 144, VT_PITCH = 560, KS_BYTES = 272 * KS_PITCH, VT_OFF = KS_BYTES;

__device__ __forceinline__ void attn_job(const LAS unsigned char* Ks, const LAS unsigned char* Vt, const bf16* qptr, float slope, float sink,
                                         int qpos, int jt0, int keymin, bf16* optr, int lane) {
    const int c = lane & 15, g = lane >> 4;
    bf16x8 qf[2];
#pragma unroll
    for (int ks = 0; ks < 2; ++ks) qf[ks] = *(const bf16x8*)(qptr + 32 * ks + 8 * g);
    f32x4 o[4];
#pragma unroll
    for (int dt = 0; dt < 4; ++dt) o[dt] = (f32x4){0.f, 0.f, 0.f, 0.f};
    float mx = sink, sum = 0.f;
#pragma unroll 1
    for (int s = 0; s < 5; ++s) {
        const int jt = jt0 + 2 * s;
        f32x4 st[2];
#pragma unroll
        for (int t = 0; t < 2; ++t) {
            f32x4 a = (f32x4){0.f, 0.f, 0.f, 0.f};
#pragma unroll
            for (int ks = 0; ks < 2; ++ks) {
                const bf16x8 kf = *(const LAS bf16x8*)(Ks + (16 * (jt + t) + c) * KS_PITCH + (32 * ks + 8 * g) * 2);
                a = __builtin_amdgcn_mfma_f32_16x16x32_bf16(kf, qf[ks], a, 0, 0, 0);
            }
            st[t] = a;
        }
        float lm = -1e30f;
#pragma unroll
        for (int t = 0; t < 2; ++t)
#pragma unroll
            for (int i = 0; i < 4; ++i) {
                const int key = 16 * (jt + t) + 4 * g + i, dist = qpos - key;
                const bool valid = dist >= 0 && dist <= 128 && key >= keymin;
                const float sc = valid ? st[t][i] * 0.125f - slope * (float)dist : -1e30f;
                st[t][i] = sc; lm = fmaxf(lm, sc);
            }
        lm = fmaxf(lm, __shfl_xor(lm, 16)); lm = fmaxf(lm, __shfl_xor(lm, 32));
        const float mn = fmaxf(mx, lm), alpha = __expf(mx - mn);
        mx = mn; sum *= alpha;
#pragma unroll
        for (int dt = 0; dt < 4; ++dt) o[dt] = o[dt] * alpha;
#pragma unroll
        for (int t = 0; t < 2; ++t)
#pragma unroll
            for (int i = 0; i < 4; ++i) { const float p = __expf(st[t][i] - mn); st[t][i] = p; sum += p; }
        v4u pw; pw.x = pk2(st[0][0], st[0][1]); pw.y = pk2(st[0][2], st[0][3]); pw.z = pk2(st[1][0], st[1][1]); pw.w = pk2(st[1][2], st[1][3]);
        const bf16x8 pb = __builtin_bit_cast(bf16x8, pw);
#pragma unroll
        for (int dt = 0; dt < 4; ++dt) {
            const LAS unsigned char* vp = Vt + (16 * dt + c) * VT_PITCH + (16 * jt + 4 * g) * 2;
            const v2u lo = *(const LAS v2u*)vp, hi = *(const LAS v2u*)(vp + 32);
            v4u vw; vw.x = lo.x; vw.y = lo.y; vw.z = hi.x; vw.w = hi.y;
            o[dt] = __builtin_amdgcn_mfma_f32_16x16x32_bf16(__builtin_bit_cast(bf16x8, vw), pb, o[dt], 0, 0, 0);
        }
    }
    sum += __shfl_xor(sum, 16); sum += __shfl_xor(sum, 32); sum += __expf(sink - mx);
    const float inv = 1.0f / sum;
#pragma unroll
    for (int dt = 0; dt < 4; ++dt) { v2u w; w.x = pk2(o[dt][0] * inv, o[dt][1] * inv); w.y = pk2(o[dt][2] * inv, o[dt][3] * inv); *(v2u*)(optr + 16 * dt + 4 * g) = w; }
}

__device__ __forceinline__ void attn_phase(const Args& a, LAS unsigned char* lds, int tid, int lane, int wave) {
    const bf16* QKV = (const bf16*)(a.ws + WS_QKV); bf16* ATT = (bf16*)(a.ws + WS_ATT);
    const float* cache_k = a.in[2]; const float* cache_v = a.in[3]; const float* sinks = a.in[8];
    float* out = a.out;
    LAS unsigned char* Ks = lds; LAS unsigned char* Vt = lds + VT_OFF;
    const int c = lane & 15;
    for (int unit = blockIdx.x; unit < 768; unit += gridDim.x) {
        __syncthreads();
        if (unit < 256) {
            const int b = unit >> 6, nb = (unit >> 2) & 15, kvh = unit & 3;
#pragma unroll 1
            for (int ch = tid; ch < 272 * 8; ch += NTHR) {
                const int j = ch >> 3, part = ch & 7, tok = (nb - 1) * 128 + j;
                v4u kk = (v4u){0u, 0u, 0u, 0u}, vv = (v4u){0u, 0u, 0u, 0u};
                if (j < 256 && tok >= 0) {
                    const bf16* src = QKV + (size_t)(b * SEQ + tok) * NIN + QK_OFF + kvh * 64 + part * 8;
                    kk = *(const v4u*)src; vv = *(const v4u*)(src + 256);
                    if (nb == 15 && j >= 128) {
                        float* ko = out + O_KWP + ((size_t)(b * 128 + j - 128) * 4 + kvh) * 64 + part * 8; float* vo = out + O_VWP + ((size_t)(b * 128 + j - 128) * 4 + kvh) * 64 + part * 8;
                        *(f32x4*)ko = (f32x4){bflo(kk.x), bfhi(kk.x), bflo(kk.y), bfhi(kk.y)}; *(f32x4*)(ko + 4) = (f32x4){bflo(kk.z), bfhi(kk.z), bflo(kk.w), bfhi(kk.w)};
                        *(f32x4*)vo = (f32x4){bflo(vv.x), bfhi(vv.x), bflo(vv.y), bfhi(vv.y)}; *(f32x4*)(vo + 4) = (f32x4){bflo(vv.z), bfhi(vv.z), bflo(vv.w), bfhi(vv.w)};
                    }
                }
                *(LAS v4u*)(Ks + j * KS_PITCH + part * 16) = kk;
                LAS unsigned short* vt = (LAS unsigned short*)(Vt + (part * 8) * VT_PITCH + j * 2);
                vt[0 * (VT_PITCH / 2)] = (unsigned short)(vv.x & 0xffffu); vt[1 * (VT_PITCH / 2)] = (unsigned short)(vv.x >> 16);
                vt[2 * (VT_PITCH / 2)] = (unsigned short)(vv.y & 0xffffu); vt[3 * (VT_PITCH / 2)] = (unsigned short)(vv.y >> 16);
                vt[4 * (VT_PITCH / 2)] = (unsigned short)(vv.z & 0xffffu); vt[5 * (VT_PITCH / 2)] = (unsigned short)(vv.z >> 16);
                vt[6 * (VT_PITCH / 2)] = (unsigned short)(vv.w & 0xffffu); vt[7 * (VT_PITCH / 2)] = (unsigned short)(vv.w >> 16);
            }
            __syncthreads();
            const int rt = wave;
            const size_t qrow = (size_t)(b * SEQ + nb * 128 + 16 * rt + c);
#pragma unroll 1
            for (int hq = 0; hq < 4; ++hq) {
                const int h = kvh * 4 + hq;
                const float slope = exp2f(-0.5f * (float)(h + 1)), sink = sinks[h];
                attn_job(Ks, Vt, QKV + qrow * NIN + h * 64, slope, sink, 16 * rt + c + 128, rt, nb > 0 ? 0 : 128, ATT + qrow * 1024 + h * 64, lane);
            }
        } else {
            const int su = unit - 256, b = su >> 2, kvh = su & 3;
#pragma unroll 1
            for (int ch = tid; ch < 160 * 8; ch += NTHR) {
                const int j = ch >> 3, part = ch & 7;
                v4u kk = (v4u){0u, 0u, 0u, 0u}, vv = (v4u){0u, 0u, 0u, 0u};
                if (j < 128) {
                    const size_t off = ((size_t)(b * 128 + j) * 4 + kvh) * 64 + part * 8;
                    const f32x4 k0 = *(const f32x4*)(cache_k + off), k1 = *(const f32x4*)(cache_k + off + 4), v0 = *(const f32x4*)(cache_v + off), v1 = *(const f32x4*)(cache_v + off + 4);
                    kk.x = pk2(k0.x, k0.y); kk.y = pk2(k0.z, k0.w); kk.z = pk2(k1.x, k1.y); kk.w = pk2(k1.z, k1.w);
                    vv.x = pk2(v0.x, v0.y); vv.y = pk2(v0.z, v0.w); vv.z = pk2(v1.x, v1.y); vv.w = pk2(v1.z, v1.w);
                    if (j >= 8) { const size_t oo = ((size_t)(b * 128 + j - 8) * 4 + kvh) * 64 + part * 8;
                        *(f32x4*)(out + O_KWS + oo) = k0; *(f32x4*)(out + O_KWS + oo + 4) = k1; *(f32x4*)(out + O_VWS + oo) = v0; *(f32x4*)(out + O_VWS + oo + 4) = v1; }
                } else if (j < 136) {
                    const bf16* src = QKV + (size_t)(MP + b * 8 + j - 128) * NIN + QK_OFF + kvh * 64 + part * 8;
                    kk = *(const v4u*)src; vv = *(const v4u*)(src + 256);
                    const size_t oo = ((size_t)(b * 128 + j - 8) * 4 + kvh) * 64 + part * 8;
                    float* ko = out + O_KWS + oo; float* vo = out + O_VWS + oo;
                    *(f32x4*)ko = (f32x4){bflo(kk.x), bfhi(kk.x), bflo(kk.y), bfhi(kk.y)}; *(f32x4*)(ko + 4) = (f32x4){bflo(kk.z), bfhi(kk.z), bflo(kk.w), bfhi(kk.w)};
                    *(f32x4*)vo = (f32x4){bflo(vv.x), bfhi(vv.x), bflo(vv.y), bfhi(vv.y)}; *(f32x4*)(vo + 4) = (f32x4){bflo(vv.z), bfhi(vv.z), bflo(vv.w), bfhi(vv.w)};
                }
                *(LAS v4u*)(Ks + j * KS_PITCH + part * 16) = kk;
                LAS unsigned short* vt = (LAS unsigned short*)(Vt + (part * 8) * VT_PITCH + j * 2);
                vt[0 * (VT_PITCH / 2)] = (unsigned short)(vv.x & 0xffffu); vt[1 * (VT_PITCH / 2)] = (unsigned short)(vv.x >> 16);
                vt[2 * (VT_PITCH / 2)] = (unsigned short)(vv.y & 0xffffu); vt[3 * (VT_PITCH / 2)] = (unsigned short)(vv.y >> 16);
                vt[4 * (VT_PITCH / 2)] = (unsigned short)(vv.z & 0xffffu); vt[5 * (VT_PITCH / 2)] = (unsigned short)(vv.z >> 16);
                vt[6 * (VT_PITCH / 2)] = (unsigned short)(vv.w & 0xffffu); vt[7 * (VT_PITCH / 2)] = (unsigned short)(vv.w >> 16);
            }
            __syncthreads();
            if (wave < 2) {
                const int qi = c & 7, h = kvh * 4 + 2 * wave + (c >> 3);
                const float slope = exp2f(-0.5f * (float)(h + 1)), sink = sinks[h];
                const size_t qrow = (size_t)(MP + b * 8 + qi);
                attn_job(Ks, Vt, QKV + qrow * NIN + h * 64, slope, sink, qi + 128, 0, 0, ATT + qrow * 1024 + h * 64, lane);
            }
        }
    }
}

__device__ __forceinline__ void load16bf(const bf16* p, float (&f)[16]) {
    const v4u a = *(const v4u*)p, b = *(const v4u*)(p + 8);
    f[0] = bflo(a.x); f[1] = bfhi(a.x); f[2] = bflo(a.y); f[3] = bfhi(a.y); f[4] = bflo(a.z); f[5] = bfhi(a.z); f[6] = bflo(a.w); f[7] = bfhi(a.w);
    f[8] = bflo(b.x); f[9] = bfhi(b.x); f[10] = bflo(b.y); f[11] = bfhi(b.y); f[12] = bflo(b.z); f[13] = bfhi(b.z); f[14] = bflo(b.w); f[15] = bfhi(b.w);
}
__device__ __forceinline__ void store16bf(bf16* p, const float (&f)[16]) {
    v4u a, b; a.x = pk2(f[0], f[1]); a.y = pk2(f[2], f[3]); a.z = pk2(f[4], f[5]); a.w = pk2(f[6], f[7]); b.x = pk2(f[8], f[9]); b.y = pk2(f[10], f[11]); b.z = pk2(f[12], f[13]); b.w = pk2(f[14], f[15]);
    *(v4u*)p = a; *(v4u*)(p + 8) = b;
}
__device__ __forceinline__ void load16f(const float* p, float (&f)[16]) {
#pragma unroll
    for (int q = 0; q < 4; ++q) { const f32x4 v = *(const f32x4*)(p + 4 * q); f[4 * q] = v.x; f[4 * q + 1] = v.y; f[4 * q + 2] = v.z; f[4 * q + 3] = v.w; }
}
__device__ __forceinline__ void store16f(float* p, const float (&f)[16]) {
#pragma unroll
    for (int q = 0; q < 4; ++q) *(f32x4*)(p + 4 * q) = (f32x4){f[4 * q], f[4 * q + 1], f[4 * q + 2], f[4 * q + 3]};
}
__device__ __forceinline__ void mix_row(const Args& a, int r, int lane) {
    const bf16* QKV = (const bf16*)(a.ws + WS_QKV); const bf16* ATT = (const bf16*)(a.ws + WS_ATT); bf16* MIX = (bf16*)(a.ws + WS_MIX);
    const float* state_conv = a.in[4]; const float* conv_w = a.in[9]; const float* gA = a.in[10]; const float* gB = a.in[11];
    const int c0 = lane * 16;
    float x[16], gg[16];
    load16bf(ATT + (size_t)r * 1024 + c0, x);
    float s = 0.f;
#pragma unroll
    for (int e = 0; e < 16; ++e) s += x[e] * x[e];
    float rs = rsqrtf(wave_sum(s) * (1.0f / 1024.0f) + EPS);
    load16f(gA + c0, gg);
#pragma unroll
    for (int e = 0; e < 16; ++e) x[e] = x[e] * rs * gg[e];
    store16bf(MIX + (size_t)r * 2048 + c0, x);
    float Bv[16], Cv[16], Uv[16], cu[16], p1[16], p2[16], w0[16], w1[16], w2[16];
    const bf16* qr = QKV + (size_t)r * NIN;
    load16bf(qr + QB_OFF + c0, Bv); load16bf(qr + QC_OFF + c0, Cv); load16bf(qr + QU_OFF + c0, Uv);
#pragma unroll
    for (int e = 0; e < 16; ++e) { cu[e] = Cv[e] * Uv[e]; p1[e] = 0.f; p2[e] = 0.f; }
    int t, nseq; float* cs_out;
    if (r < MP) { t = r & (SEQ - 1); nseq = SEQ; cs_out = a.out + O_CVP + (size_t)((r >> 11) * 2) * 1024 + c0; }
    else { t = (r - MP) & 7; nseq = 8; cs_out = a.out + O_CVS + (size_t)(((r - MP) >> 3) * 2) * 1024 + c0; }
    if (t >= 1) { load16bf(qr - NIN + QC_OFF + c0, Cv); load16bf(qr - NIN + QU_OFF + c0, Uv);
#pragma unroll
        for (int e = 0; e < 16; ++e) p1[e] = Cv[e] * Uv[e]; }
    else if (r >= MP) load16f(state_conv + (size_t)(((r - MP) >> 3) * 2 + 1) * 1024 + c0, p1);
    if (t >= 2) { load16bf(qr - 2 * NIN + QC_OFF + c0, Cv); load16bf(qr - 2 * NIN + QU_OFF + c0, Uv);
#pragma unroll
        for (int e = 0; e < 16; ++e) p2[e] = Cv[e] * Uv[e]; }
    else if (r >= MP) load16f(state_conv + (size_t)(((r - MP) >> 3) * 2 + t) * 1024 + c0, p2);
    if (t >= nseq - 2) store16f(cs_out + (size_t)(t - (nseq - 2)) * 1024, cu);
    load16f(conv_w + c0, w0); load16f(conv_w + 1024 + c0, w1); load16f(conv_w + 2048 + c0, w2);
    s = 0.f;
#pragma unroll
    for (int e = 0; e < 16; ++e) { x[e] = Bv[e] * (w0[e] * p2[e] + w1[e] * p1[e] + w2[e] * cu[e]); s += x[e] * x[e]; }
    rs = rsqrtf(wave_sum(s) * (1.0f / 1024.0f) + EPS);
    load16f(gB + c0, gg);
#pragma unroll
    for (int e = 0; e < 16; ++e) x[e] = x[e] * rs * gg[e];
    store16bf(MIX + (size_t)r * 2048 + 1024 + c0, x);
}

__device__ __forceinline__ void fixup_phase(const Args& a, int gtid, int gthreads) {
    const float* SG = (const float*)(a.ws + WS_SG); const float* SU = (const float*)(a.ws + WS_SU); const float* TG = (const float*)(a.ws + WS_TG);
    const float* cw = a.in[16]; const float* cb = a.in[17]; bf16* HM = (bf16*)(a.ws + WS_HM);
    constexpr int C4 = DFF / 4;
    for (int it = gtid; it < 128 * 2 * C4; it += gthreads) {
        const int c = (it % C4) * 4, bi = it / C4, i = bi & 1, blk = bi >> 1;
        const bool start = (blk & 31) == 0;
        const f32x4 z = (f32x4){0.f, 0.f, 0.f, 0.f};
        const f32x4 g0 = *(const f32x4*)(SG + (size_t)(blk * 2 + i) * DFF + c), u0 = *(const f32x4*)(SU + (size_t)(blk * 2 + i) * DFF + c);
        f32x4 p1, p2;
        if (i == 0) { p1 = start ? z : *(const f32x4*)(TG + (size_t)((blk - 1) * 2 + 1) * DFF + c); p2 = start ? z : *(const f32x4*)(TG + (size_t)((blk - 1) * 2) * DFF + c); }
        else { p1 = *(const f32x4*)(SG + (size_t)(blk * 2) * DFF + c); p2 = start ? z : *(const f32x4*)(TG + (size_t)((blk - 1) * 2 + 1) * DFF + c); }
        const f32x4 w0 = *(const f32x4*)(cw + c), w1 = *(const f32x4*)(cw + DFF + c), w2 = *(const f32x4*)(cw + 2 * DFF + c), bb = *(const f32x4*)(cb + c);
        float h[4];
#pragma unroll
        for (int e = 0; e < 4; ++e) { const float av = w0[e] * p2[e] + w1[e] * p1[e] + w2[e] * g0[e] + bb[e]; h[e] = pg8::silu_f(av) * u0[e]; }
        v2u w; w.x = pk2(h[0], h[1]); w.y = pk2(h[2], h[3]);
        *(v2u*)(HM + (size_t)(blk * 64 + i) * DFF + c) = w;
    }
}

__device__ __forceinline__ void final_row(float* row, const float* g, const float* part, size_t pstride, int lane) {
    f32x4* xr = (f32x4*)row + lane; const f32x4* gr = (const f32x4*)g + lane;
    f32x4 v[8]; float s = 0.f;
#pragma unroll
    for (int j = 0; j < 8; ++j) v[j] = xr[64 * j];
    if (part) {
#pragma unroll 1
        for (int p = 0; p < 8; ++p) { const f32x4* pr = (const f32x4*)(part + p * pstride) + lane;
#pragma unroll
            for (int j = 0; j < 8; ++j) v[j] = v[j] + pr[64 * j]; }
    }
#pragma unroll
    for (int j = 0; j < 8; ++j) s += (v[j].x * v[j].x + v[j].y * v[j].y) + (v[j].z * v[j].z + v[j].w * v[j].w);
    const float rs = rsqrtf(wave_sum(s) * (1.0f / 2048.0f) + EPS);
#pragma unroll
    for (int j = 0; j < 8; ++j) { const f32x4 gg = gr[64 * j]; xr[64 * j] = (f32x4){v[j].x * rs * gg.x, v[j].y * rs * gg.y, v[j].z * rs * gg.z, v[j].w * rs * gg.w}; }
}

#define XB_TMO      128
#define XB_XCNT(j)  (256  + 64 * (j))
#define XB_XSUB(j)  (1280 + 64 * (j))
#define XB_XGEN(j)  (2304 + 64 * (j))
#define XB_TOP      3328
#define XB_TOPGEN   3392
#define XCD_BAR_WORDS 3456
#define XB_SPIN_CAP (1u << 18)

__device__ __forceinline__ unsigned xb_ld(unsigned* p)              { return __hip_atomic_load(p, __ATOMIC_RELAXED, __HIP_MEMORY_SCOPE_AGENT); }
__device__ __forceinline__ unsigned xb_add(unsigned* p, unsigned v) { return __hip_atomic_fetch_add(p, v, __ATOMIC_RELAXED, __HIP_MEMORY_SCOPE_AGENT); }
__device__ __forceinline__ unsigned xb_xcc_id() { return (unsigned)__builtin_amdgcn_s_getreg((3 << 11) | 20) & 0xFu; }
#define XB_SPIN(cond, bar) do { unsigned _sp = 0; while (cond) { __builtin_amdgcn_s_sleep(1); \
    if ((++_sp & 255u) == 0u) { if (xb_ld(&(bar)[XB_TMO])) break; if (_sp > XB_SPIN_CAP) { atomicAdd(&(bar)[XB_TMO], 1u); break; } } } } while (0)

struct XcdBarrier {
    unsigned* bar; unsigned x;
    volatile LAS unsigned* st;
};

__device__ __forceinline__ XcdBarrier xcd_barrier_post(unsigned* bar, volatile LAS unsigned* st) {
    XcdBarrier b; b.bar = bar; b.x = xb_xcc_id(); b.st = st;
    if (threadIdx.x == 0) (void)xb_add(&bar[XB_XCNT(b.x)], 1u);
    return b;
}
__device__ __forceinline__ void xcd_barrier_complete(unsigned* bar, unsigned x, unsigned& nloc, unsigned& nx) {
    const unsigned G = gridDim.x * gridDim.y * gridDim.z;
    unsigned sum, cnt, mine, sp = 0u;
    for (;;) {
        sum = 0u; cnt = 0u; mine = 0u;
#pragma unroll
        for (unsigned j = 0; j < 16; ++j) { const unsigned c = xb_ld(&bar[XB_XCNT(j)]); sum += c; cnt += (c > 0u) ? 1u : 0u; mine = (j == x) ? c : mine; }
        if (sum == G) break;
        __builtin_amdgcn_s_sleep(1);
        if ((++sp & 255u) == 0u) { if (xb_ld(&bar[XB_TMO])) break; if (sp > XB_SPIN_CAP) { atomicAdd(&bar[XB_TMO], 1u); break; } }
    }
    nloc = mine > 0u ? mine : 1u; nx = cnt > 0u ? cnt : 1u;
}

__device__ __forceinline__ void xcd_barrier(const XcdBarrier& b) {
    asm volatile("s_waitcnt vmcnt(0)" ::: "memory");
    __syncthreads();
    if (threadIdx.x == 0) {
        unsigned* bar = b.bar;
        __builtin_amdgcn_s_waitcnt(0);
        unsigned nloc = b.st[0], nx = b.st[1];
        if (nloc == 0u) { xcd_barrier_complete(bar, b.x, nloc, nx); b.st[0] = nloc; b.st[1] = nx; }
        const unsigned old = xb_add(&bar[XB_XSUB(b.x)], 1u);
        const unsigned gen = old / nloc;
        if (old + 1u == (gen + 1u) * nloc) {
            __builtin_amdgcn_fence(__ATOMIC_RELEASE, "agent");
            asm volatile("s_waitcnt vmcnt(0)" ::: "memory");
            const unsigned og = xb_add(&bar[XB_TOP], 1u);
            const unsigned tg = og / nx;
            if (og + 1u == (tg + 1u) * nx) xb_add(&bar[XB_TOPGEN], 1u);
            else XB_SPIN(xb_ld(&bar[XB_TOPGEN]) == tg, bar);
            __builtin_amdgcn_fence(__ATOMIC_ACQUIRE, "agent");
            xb_add(&bar[XB_XGEN(b.x)], 1u);
            asm volatile("s_waitcnt vmcnt(0)" ::: "memory");
        } else {
            XB_SPIN(xb_ld(&bar[XB_XGEN(b.x)]) == gen, bar);
            __builtin_amdgcn_fence(__ATOMIC_ACQUIRE, "agent");
            asm volatile("s_waitcnt vmcnt(0)" ::: "memory");
        }
    }
    __syncthreads();
}


#ifndef ONE_LAUNCH
#define ONE_LAUNCH 1
#endif
constexpr int NPHASE = 9;


__global__ void __launch_bounds__(NTHR, 2) hymba_fwd(Args a) {
    extern __shared__ __attribute__((aligned(16))) unsigned char lds_raw[];
    LAS unsigned char* lds = (LAS unsigned char*)lds_raw;
    cg::grid_group grid = cg::this_grid();
    const int tid = threadIdx.x, lane = tid & 63, wave = __builtin_amdgcn_readfirstlane(tid >> 6);
    const int G = gridDim.x, bx = blockIdx.x;
    const int vcu = (G % 8 == 0) ? (bx % 8) * (G / 8) + bx / 8 : bx;
    const int gw = vcu * NWAVES + wave, NGW = G * NWAVES;
    const int lo = a.ph_lo, hi = a.ph_hi;
    unsigned char* ws = a.ws;
#ifndef PHMASK
#define PHMASK 0x1ff
#endif
#define IN(k) (((PHMASK >> (k)) & 1) && lo <= (k) && (k) < hi)
#ifndef TMASK
#define TMASK 0
#endif
    unsigned long long t_prev = TMASK ? __builtin_amdgcn_s_memrealtime() : 0ull, t_acc = 0ull;
#define SEAM(k) do { if (IN(k) && IN((k) + 1)) xcd_barrier(xbar); if (TMASK) { const unsigned long long now_ = __builtin_amdgcn_s_memrealtime(); if ((TMASK >> (k)) & 1) t_acc += now_ - t_prev; t_prev = now_; } } while (0)
    if (tid < 4) ((LAS unsigned*)(lds + LDS_XB_OFF))[tid] = 0u;
    __syncthreads();
    XcdBarrier xbar = xcd_barrier_post((unsigned*)(ws + WS_BAR), (volatile LAS unsigned*)(lds + LDS_XB_OFF));
    if (hi > 1000) grid.sync();

    if (IN(0)) {
        LAS float* scr = (LAS float*)(lds + wave * 16384);
        constexpr int I_IN = (DM / 64) * (NIN / 32);
        for (int it = gw; it < I_IN; it += NGW) p0_transpose_item<0>(a.in[7], DM, NIN, (bf16*)(ws + WS_WIN), nullptr, scr, it, lane);
        for (int m = gw; m < MT; m += NGW) {
            const float* xrow = m < MP ? a.in[0] + (size_t)m * DM : a.in[1] + (size_t)(m - MP) * DM;
            rms_row_to_bf16(xrow, a.in[6], (bf16*)(ws + WS_H) + (size_t)m * DM, lane);
        }
        for (int i = bx * NTHR + tid; i < MT; i += G * NTHR) ((float*)(ws + WS_SS1))[i] = 0.f;
    }
    SEAM(0);
    if (IN(1)) {
        __syncthreads();
        pg8::Gemm g{(const pg8::bf16_t*)(ws + WS_H), (const pg8::bf16_t*)(ws + WS_WIN), MT, NIN, DM}; pg8::StaticOrder S; S.init(MT, NIN, G, bx);
        pg8::EpiBf16<0> E{(pg8::bf16_t*)(ws + WS_QKV), NIN, nullptr, 0, 0, 1.f};
        pg8::gemm_phase<pg8::EpiBf16<0>, pg8::StaticOrder, true, true>(lds, g, S, E);
        IDLE_CONVERT((MT / 256) * (NIN / 256), 0, VI_CUT1);
    }
    SEAM(1);
    if (IN(2)) { __syncthreads(); attn_phase(a, lds, tid, lane, wave); }
    SEAM(2);
    if (IN(3)) { for (int m = gw; m < MT; m += NGW) mix_row(a, m, lane); }
    SEAM(3);
    if (IN(4)) {
        __syncthreads();
        pg8::Gemm g{(const pg8::bf16_t*)(ws + WS_MIX), (const pg8::bf16_t*)(ws + WS_WOUT), MT, DM, DM}; pg8::StaticOrder S; S.init(MT, DM, G, bx);
        pg8::EpiRes E{a.in[0], a.in[1], a.out + O_Y, (pg8::bf16_t*)(ws + WS_H), (float*)(ws + WS_SS1), nullptr};
        pg8::gemm_phase<pg8::EpiRes, pg8::StaticOrder, true, true>(lds, g, S, E);
        IDLE_CONVERT((MT / 256) * (DM / 256), VI_CUT1, VI_CUT2);
    }
    SEAM(4);
    if (IN(5)) {
        __syncthreads();
        pg8::Gemm g{(const pg8::bf16_t*)(ws + WS_H), (const pg8::bf16_t*)(ws + WS_WGU), MT, 2 * DFF, DM}; pg8::StaticOrder S; S.init(MT, 2 * DFF, G, bx);
        pg8::EpiGU E{(pg8::bf16_t*)(ws + WS_HM), (const float*)(ws + WS_SS1), a.in[16], a.in[17], a.in[5],
                     (float*)(ws + WS_SG), (float*)(ws + WS_SU), (float*)(ws + WS_TG), a.out + O_FFP, a.out + O_FFS};
        pg8::gemm_phase<pg8::EpiGU, pg8::StaticOrder, true, true>(lds, g, S, E);
        IDLE_CONVERT((MT / 256) * (2 * DFF / 256), VI_CUT2, VI_END);
    }
    SEAM(5);
    if (IN(6)) fixup_phase(a, bx * NTHR + tid, G * NTHR);
    SEAM(6);
    if (IN(7)) {
        __syncthreads();
        pg8::Gemm g{(const pg8::bf16_t*)(ws + WS_HM), (const pg8::bf16_t*)(ws + WS_WDN), MT, DM, DFF}; pg8::SplitOrder S; S.init(DM, G, bx, 12, 10);
        pg8::EpiRes E{a.out + O_Y, a.out + O_Y + (size_t)MP * DM, a.out + O_Y, nullptr, nullptr, G == 256 ? (float*)(ws + WS_H) : nullptr};
        pg8::gemm_phase<pg8::EpiRes, pg8::SplitOrder, true, true>(lds, g, S, E);
    }
    SEAM(7);
    if (IN(8)) { for (int m = gw; m < MT; m += NGW) final_row(a.out + O_Y + (size_t)m * DM, a.in[19], (G == 256 && m >= MP) ? (const float*)(ws + WS_H) + (size_t)(m - MP) * DM : nullptr, (size_t)1024 * DM, lane); }
    SEAM(8);
    if (TMASK && bx == 0 && tid == 0) { const unsigned long long t_end = t_prev + t_acc; while (__builtin_amdgcn_s_memrealtime() < t_end) __builtin_amdgcn_s_sleep(8); }
#undef IN
#undef SEAM
}

extern "C" void kernel_launch(void* const* d_in, const int* in_sizes, int n_in, void* d_out, int out_size, void* d_ws, size_t ws_size, hipStream_t stream) {
    static int grid = 0;
    if (grid == 0) {
        if (n_in != 20 || out_size != (int)O_END || ws_size < WS_END) { fprintf(stderr, "kernel_launch: unexpected shapes (n_in %d, out %d, ws %zu)\n", n_in, out_size, ws_size); grid = -1; return; }
        int dev = 0, cus = 0, per_cu = 0;
        (void)hipGetDevice(&dev); (void)hipDeviceGetAttribute(&cus, hipDeviceAttributeMultiprocessorCount, dev);
        if (hipFuncSetAttribute((const void*)hymba_fwd, hipFuncAttributeMaxDynamicSharedMemorySize, LDS_BYTES) != hipSuccess) { fprintf(stderr, "kernel_launch: hipFuncSetAttribute failed\n"); grid = -1; return; }
        if (hipOccupancyMaxActiveBlocksPerMultiprocessor(&per_cu, (const void*)hymba_fwd, NTHR, LDS_BYTES) != hipSuccess || per_cu < 1) { fprintf(stderr, "kernel_launch: occupancy query says %d\n", per_cu); per_cu = 1; }
        (void)hipGetLastError();
        grid = cus * per_cu;
        fprintf(stderr, "kernel_launch: grid %d (cus %d x %d)\n", grid, cus, per_cu);
    }
    if (grid < 0) return;
    (void)hipMemsetAsync(d_ws, 0, CTL_ZERO_BYTES, stream);
    Args a{};
    for (int i = 0; i < 20; ++i) a.in[i] = (const float*)d_in[i];
    a.out = (float*)d_out; a.ws = (unsigned char*)d_ws;
#if ONE_LAUNCH
    a.ph_lo = 0; a.ph_hi = NPHASE;
    void* args[] = {&a};
    hipError_t e = hipLaunchCooperativeKernel((const void*)hymba_fwd, dim3(grid), dim3(NTHR), args, LDS_BYTES, stream);
    if (e != hipSuccess) fprintf(stderr, "kernel_launch: cooperative launch failed: %s (grid %d)\n", hipGetErrorString(e), grid);
#else
    for (int p = 0; p < NPHASE; ++p) {
        a.ph_lo = p; a.ph_hi = p + 1;
        hipLaunchKernelGGL(hymba_fwd, dim3(grid), dim3(NTHR), LDS_BYTES, stream, a);
    }
#endif
}
```
